# Optimizing an MI355X kernel written in HIP

```python
import math
import jax
import jax.numpy as jnp
from jax import lax
import numpy as np

D_MODEL = 1024
BATCH = 8
SEQ = 8192
DEPTH = 2

DA_HEAD_DIM = 64
DA_V_DIM = 2 * DA_HEAD_DIM
DA_WIDTH = D_MODEL // 2
DA_HEADS = DA_WIDTH // DA_V_DIM
POOL_WIDTH = D_MODEL // 4
POOL_WINDOWS = (2, 4, 8, 16)
POOL_GROUPS = len(POOL_WINDOWS)
POOL_GROUP_DIM = POOL_WIDTH // POOL_GROUPS
RET_WIDTH = D_MODEL // 4
RET_HEAD_DIM = 64
RET_HEADS = RET_WIDTH // RET_HEAD_DIM
RET_CHUNK = 128
MIX_WIDTH = DA_WIDTH + POOL_WIDTH + RET_WIDTH
IN_SECTIONS = (DA_WIDTH, DA_WIDTH, DA_WIDTH, POOL_WIDTH, RET_WIDTH, RET_WIDTH, RET_WIDTH, RET_WIDTH)
IN_WIDTH = sum(IN_SECTIONS)
IN_SPLITS = tuple(int(s) for s in np.cumsum(IN_SECTIONS)[:-1])
BLOCK_Q = 128
REL_BUCKETS = 32
REL_MAX_DIST = 128
FFN_DIM = 2816
N_EXPERTS = 8
TOP_K = 2
EXPERT_DIM = 3584
MOE_BLOCK = 512
ALPHA = (2 * DEPTH) ** 0.25
BETA = (8 * DEPTH) ** -0.25
LN_EPS = 1e-5
NORM_EPS = 1e-6

kernel_name = 'hymba_style_diffattn_pool_retention_moe'


def layer_norm(x, g, b):
    xf = x.astype(jnp.float32)
    mu = jnp.mean(xf, axis=-1, keepdims=True)
    var = jnp.mean(jnp.square(xf - mu), axis=-1, keepdims=True)
    return ((xf - mu) * lax.rsqrt(var + LN_EPS) * g + b).astype(x.dtype)


def t5_bucket(dist):
    n = jnp.maximum(dist, 0)
    max_exact = REL_BUCKETS // 2
    nf = jnp.maximum(n, 1).astype(jnp.float32)
    large = max_exact + (jnp.log(nf / max_exact) / math.log(REL_MAX_DIST / max_exact)
                         * (REL_BUCKETS - max_exact)).astype(jnp.int32)
    large = jnp.minimum(large, REL_BUCKETS - 1)
    return jnp.where(n < max_exact, n, large)


def diff_attention(q, k, v, rel_bias, lam, lam_init, subln_g):
    B, S = q.shape[0], q.shape[1]
    nqb = S // BLOCK_Q
    scale = DA_HEAD_DIM ** -0.5
    kh = k.transpose(0, 2, 3, 1, 4)
    vh = v.transpose(0, 2, 1, 3)
    q_blocks = q.transpose(0, 2, 3, 1, 4).reshape(B, DA_HEADS, 2, nqb, BLOCK_Q, DA_HEAD_DIM)
    q_blocks = q_blocks.transpose(3, 0, 1, 2, 4, 5)
    table = rel_bias.astype(jnp.float32).reshape(REL_BUCKETS, DA_HEADS, 2)
    k_pos = jnp.arange(S)

    def one_block(args):
        qb, b_idx = args
        q_pos = b_idx * BLOCK_Q + jnp.arange(BLOCK_Q)
        dist = q_pos[:, None] - k_pos[None, :]
        bias = table[t5_bucket(dist)].transpose(2, 3, 0, 1)
        logits = jnp.einsum('bhmqd,bhmkd->bhmqk', qb, kh).astype(jnp.float32) * scale + bias
        logits = jnp.where(dist >= 0, logits, -1e30)
        p = jax.nn.softmax(logits, axis=-1)
        a = p[:, :, 0] - lam * p[:, :, 1]
        return jnp.einsum('bhqk,bhke->bhqe', a.astype(vh.dtype), vh)

    out = lax.map(one_block, (q_blocks, jnp.arange(nqb)))
    out = out.transpose(1, 0, 3, 2, 4).reshape(B, S, DA_HEADS, DA_V_DIM).astype(jnp.float32)
    out = out * lax.rsqrt(jnp.mean(jnp.square(out), axis=-1, keepdims=True) + NORM_EPS) * subln_g
    return (out * (1.0 - lam_init)).reshape(B, S, DA_WIDTH).astype(q.dtype)


def pool_mixer(p, pool_w, pool_scale):
    B, S, _ = p.shape
    pf = p.astype(jnp.float32).reshape(B, S, POOL_GROUPS, POOL_GROUP_DIM)
    csum = jnp.concatenate([jnp.zeros((B, 1, POOL_GROUPS, POOL_GROUP_DIM), jnp.float32),
                            jnp.cumsum(pf, axis=1)], axis=1)
    t = jnp.arange(S)
    outs = []
    for gi, w in enumerate(POOL_WINDOWS):
        lo = jnp.maximum(t + 1 - w, 0)
        cnt = jnp.minimum(t + 1, w).astype(jnp.float32)
        mean = (csum[:, 1:, gi] - csum[:, lo, gi]) / cnt[None, :, None]
        outs.append(mean - pf[:, :, gi])
    pooled = jnp.stack(outs, axis=2)
    mixed = jnp.einsum('bsgc,gcd->bsgd', pooled, pool_w.astype(jnp.float32))
    return (mixed.reshape(B, S, POOL_WIDTH) * pool_scale).astype(p.dtype)


def rotate(t, pos):
    half = t.shape[-1] // 2
    inv = 10000.0 ** (-jnp.linspace(0.0, 1.0, half, dtype=jnp.float32))
    ang = pos[:, None].astype(jnp.float32) * inv[None, :]
    cos = jnp.cos(ang)[None, :, None, :]
    sin = jnp.sin(ang)[None, :, None, :]
    t1 = t[..., :half].astype(jnp.float32)
    t2 = t[..., half:].astype(jnp.float32)
    return jnp.concatenate([t1 * cos - t2 * sin, t1 * sin + t2 * cos], axis=-1)


def retention(q, k, v, g, gn_g):
    dtype = q.dtype
    B, S, H, d = q.shape
    pos = jnp.arange(S)
    q = rotate(q, pos)
    k = rotate(k, pos) * (d ** -0.5)
    log_gamma = jnp.log(1.0 - 2.0 ** (-5.0 - jnp.arange(H, dtype=jnp.float32)))
    C = RET_CHUNK
    nc = S // C
    idx = jnp.arange(C, dtype=jnp.float32)
    rel = idx[:, None] - idx[None, :]
    intra = jnp.where(rel >= 0, jnp.exp(log_gamma[:, None, None] * jnp.maximum(rel, 0.0)), 0.0)
    q_decay = jnp.exp(log_gamma[:, None] * (idx + 1.0))[..., None]
    k_decay = jnp.exp(log_gamma[:, None] * (C - 1.0 - idx))[..., None]
    chunk_decay = jnp.exp(log_gamma * C)[:, None, None]

    def to_chunks(t):
        return t.astype(jnp.float32).reshape(B, nc, C, H, d).transpose(1, 0, 3, 2, 4)

    def step(state, inp):
        qc, kc, vc = inp
        inner = jnp.einsum('bhid,bhjd->bhij', qc, kc) * intra
        y = (jnp.einsum('bhij,bhje->bhie', inner, vc)
             + jnp.einsum('bhid,bhde->bhie', qc * q_decay, state))
        state = state * chunk_decay + jnp.einsum('bhjd,bhje->bhde', kc * k_decay, vc)
        return state, y

    state0 = jnp.zeros((B, H, d, d), jnp.float32)
    _, y = lax.scan(step, state0, (to_chunks(q), to_chunks(k), to_chunks(v)))
    y = y.transpose(1, 0, 3, 2, 4).reshape(B, S, H, d)
    mu = jnp.mean(y, axis=-1, keepdims=True)
    var = jnp.mean(jnp.square(y - mu), axis=-1, keepdims=True)
    y = ((y - mu) * lax.rsqrt(var + NORM_EPS)).reshape(B, S, H * d) * gn_g
    return (jax.nn.silu(g.reshape(B, S, H * d).astype(jnp.float32)) * y).astype(dtype)


def swiglu(h, w_gate, w_up, w_down):
    return jnp.dot(jax.nn.silu(jnp.dot(h, w_gate)) * jnp.dot(h, w_up), w_down)


def moe_swiglu(h, router_w, w_gate, w_up, w_down):
    B, S, D = h.shape
    n_tok = B * S
    n_assign = n_tok * TOP_K
    hf = h.reshape(n_tok, D)
    logits = jnp.dot(hf, router_w).astype(jnp.float32)
    top_vals, top_idx = lax.top_k(logits, TOP_K)
    gates = jax.nn.softmax(top_vals, axis=-1)
    flat_e = top_idx.reshape(-1)
    order = jnp.argsort(flat_e, stable=True)
    sorted_e = flat_e[order]
    tok_sorted = (order // TOP_K).astype(jnp.int32)
    counts = jnp.bincount(flat_e, length=N_EXPERTS)
    padded = (counts + MOE_BLOCK - 1) // MOE_BLOCK * MOE_BLOCK
    pad_end = jnp.cumsum(padded)
    pad_start = pad_end - padded
    start = jnp.cumsum(counts) - counts
    dest = pad_start[sorted_e] + jnp.arange(n_assign) - start[sorted_e]
    n_slots = (n_assign + MOE_BLOCK - 1) // MOE_BLOCK * MOE_BLOCK + N_EXPERTS * MOE_BLOCK
    n_blocks = n_slots // MOE_BLOCK
    buf_tok = jnp.full((n_slots,), n_tok, jnp.int32).at[dest].set(tok_sorted)
    block_e = jnp.minimum(jnp.searchsorted(pad_end, jnp.arange(n_blocks) * MOE_BLOCK, side='right'),
                          N_EXPERTS - 1)
    h_pad = jnp.concatenate([hf, jnp.zeros((1, D), hf.dtype)], axis=0)
    xb = h_pad[buf_tok].reshape(n_blocks, MOE_BLOCK, D)

    def expert_block(args):
        xblk, e = args
        return swiglu(xblk, w_gate[e], w_up[e], w_down[e])

    yb = lax.map(expert_block, (xb, block_e)).reshape(n_slots, D)
    contrib = yb[dest] * gates.reshape(-1)[order][:, None].astype(yb.dtype)
    out = jax.ops.segment_sum(contrib, tok_sorted, num_segments=n_tok)
    return out.reshape(B, S, D)


def setup_inputs(seed: int = 0) -> dict:
    key = jax.random.key(seed)
    ks = jax.random.split(key, 22)
    n_dense = (DEPTH + 1) // 2
    n_moe = DEPTH // 2
    nrm = jax.random.normal
    f32 = jnp.float32
    return {
        'x': nrm(ks[0], (BATCH, SEQ, D_MODEL), f32),
        'rel_bias': 0.5 * nrm(ks[1], (REL_BUCKETS, 2 * DA_HEADS), f32),
        'w_in': nrm(ks[2], (DEPTH, D_MODEL, IN_WIDTH), f32) * D_MODEL ** -0.5,
        'diff_lambda': 0.1 * nrm(ks[3], (DEPTH, 4, DA_HEAD_DIM), f32),
        'diff_subln_g': 1.0 + 0.1 * nrm(ks[4], (DEPTH, DA_V_DIM), f32),
        'pool_w': nrm(ks[5], (DEPTH, POOL_GROUPS, POOL_GROUP_DIM, POOL_GROUP_DIM), f32) * POOL_GROUP_DIM ** -0.5,
        'pool_scale': 1.0 + 0.1 * nrm(ks[6], (DEPTH, POOL_WIDTH), f32),
        'ret_gn_g': 1.0 + 0.1 * nrm(ks[7], (DEPTH, RET_WIDTH), f32),
        'w_out': nrm(ks[8], (DEPTH, MIX_WIDTH, D_MODEL), f32) * (MIX_WIDTH ** -0.5 * BETA),
        'ln1_g': 1.0 + 0.1 * nrm(ks[9], (DEPTH, D_MODEL), f32),
        'ln1_b': 0.02 * nrm(ks[10], (DEPTH, D_MODEL), f32),
        'ln2_g': 1.0 + 0.1 * nrm(ks[11], (DEPTH, D_MODEL), f32),
        'ln2_b': 0.02 * nrm(ks[12], (DEPTH, D_MODEL), f32),
        'ffn_w_gate': nrm(ks[13], (n_dense, D_MODEL, FFN_DIM), f32) * D_MODEL ** -0.5,
        'ffn_w_up': nrm(ks[14], (n_dense, D_MODEL, FFN_DIM), f32) * D_MODEL ** -0.5,
        'ffn_w_down': nrm(ks[15], (n_dense, FFN_DIM, D_MODEL), f32) * (FFN_DIM ** -0.5 * BETA),
        'router_w': nrm(ks[16], (n_moe, D_MODEL, N_EXPERTS), f32) * D_MODEL ** -0.5,
        'moe_w_gate': nrm(ks[17], (n_moe, N_EXPERTS, D_MODEL, EXPERT_DIM), f32) * D_MODEL ** -0.5,
        'moe_w_up': nrm(ks[18], (n_moe, N_EXPERTS, D_MODEL, EXPERT_DIM), f32) * D_MODEL ** -0.5,
        'moe_w_down': nrm(ks[19], (n_moe, N_EXPERTS, EXPERT_DIM, D_MODEL), f32) * (EXPERT_DIM ** -0.5 * BETA),
    }


def reference(x, rel_bias, w_in, diff_lambda, diff_subln_g, pool_w, pool_scale, ret_gn_g, w_out,
              ln1_g, ln1_b, ln2_g, ln2_b, ffn_w_gate, ffn_w_up, ffn_w_down,
              router_w, moe_w_gate, moe_w_up, moe_w_down):
    B, S, D = x.shape
    for l in range(DEPTH):
        proj = jnp.dot(x, w_in[l])
        dq, dk, dv, pp, rq, rk, rv, rg = jnp.split(proj, IN_SPLITS, axis=-1)
        lam_init = 0.8 - 0.6 * math.exp(-0.3 * l)
        lq1, lk1, lq2, lk2 = [diff_lambda[l, i].astype(jnp.float32) for i in range(4)]
        lam = jnp.exp(jnp.sum(lq1 * lk1)) - jnp.exp(jnp.sum(lq2 * lk2)) + lam_init
        y_da = diff_attention(dq.reshape(B, S, DA_HEADS, 2, DA_HEAD_DIM),
                              dk.reshape(B, S, DA_HEADS, 2, DA_HEAD_DIM),
                              dv.reshape(B, S, DA_HEADS, DA_V_DIM),
                              rel_bias, lam, lam_init, diff_subln_g[l])
        y_pool = pool_mixer(pp, pool_w[l], pool_scale[l])
        rshape = (B, S, RET_HEADS, RET_HEAD_DIM)
        y_ret = retention(rq.reshape(rshape), rk.reshape(rshape), rv.reshape(rshape),
                          rg.reshape(rshape), ret_gn_g[l])
        mix = jnp.dot(jnp.concatenate([y_da, y_pool, y_ret], axis=-1), w_out[l])
        x = layer_norm(ALPHA * x + mix, ln1_g[l], ln1_b[l])
        if l % 2 == 0:
            j = l // 2
            f = swiglu(x, ffn_w_gate[j], ffn_w_up[j], ffn_w_down[j])
        else:
            j = l // 2
            f = moe_swiglu(x, router_w[j], moe_w_gate[j], moe_w_up[j], moe_w_down[j])
        x = layer_norm(ALPHA * x + f, ln2_g[l], ln2_b[l])
    return x
```

```cpp
#include <hip/hip_runtime.h>
#include <cstdio>
#include <cstdint>
#include <cmath>
#define MK_ONE_LAUNCH 0
namespace pg8 {
#define PG8_LAS __attribute__((address_space(3)))
typedef unsigned short bf16_t;
typedef short bf16x8 __attribute__((ext_vector_type(8)));
typedef float f32x4 __attribute__((ext_vector_type(4)));
typedef unsigned u32x4 __attribute__((ext_vector_type(4)));
constexpr int BM = 256, BK = 64, HALF = 128, HTB = HALF * BK * 2  , STAGE_BYTES = 8 * HTB, NXCD = 8, WGM = 8;

__host__ __device__ __forceinline__ int lds_byte(int r, int c) { const int st = (r >> 4) * 2 + (c >> 5), rr = r & 15, cc = c & 31, ob = rr * 64 + cc * 2; return st * 1024 + (ob ^ (((ob >> 9) & 1) << 5)); }
__host__ __device__ __forceinline__ void stage_rc(int b, int& R, int& C) { const int st = b / 1024, sb = b % 1024, swz = sb ^ (((sb >> 9) & 1) << 5); R = (st >> 1) * 16 + swz / 64; C = (st & 1) * 32 + (swz % 64) / 2; }
__host__ __device__ __forceinline__ int perm32(int rho) { const int n = rho >> 4, i = rho & 15; return 8 * (i >> 2) + 4 * n + (i & 3); }

struct Unit { int pm, pn, am, e; };
struct Gemm { const bf16_t* A; const bf16_t* Bt; int M, N, K; size_t bstride; };

struct StaticOrder {
    int nM, nN, nwg, G, c;
    __host__ __device__ void init(int M, int N, int G_, int c_) { nM = M / BM; nN = N / BM; nwg = nM * nN; G = G_; c = c_; }
    __host__ __device__ bool next(int i, Unit& u) const {
        const long L = (long)i * G + c; if (L >= nwg) return false;
        int wgid = (int)L; { const int q = nwg / NXCD, r = nwg % NXCD, xcd = wgid % NXCD, off = wgid / NXCD; wgid = (xcd < r ? xcd * (q + 1) : r * (q + 1) + (xcd - r) * q) + off; }
        const int nig = WGM * nN, gid = wgid / nig, fm = gid * WGM, gsz = (nM - fm) < WGM ? (nM - fm) : WGM;
        u.pm = fm + ((wgid % nig) % gsz); u.pn = (wgid % nig) / gsz; u.am = u.pm; u.e = 0; return true;
    }
    __device__ __forceinline__ void a_ready(const Unit&) const {}
    __device__ __forceinline__ void done(const Unit&) const {}
};

__device__ __forceinline__ unsigned cvt_pk_bf16(float lo, float hi) { unsigned r; asm volatile("v_cvt_pk_bf16_f32 %0, %1, %2" : "=v"(r) : "v"(lo), "v"(hi)); return r; }
typedef float f32x2 __attribute__((ext_vector_type(2)));
typedef unsigned u32x2 __attribute__((ext_vector_type(2)));
__device__ __forceinline__ float bf_lo(unsigned w) { return __uint_as_float(w << 16); }
__device__ __forceinline__ float bf_hi(unsigned w) { return __uint_as_float(w & 0xffff0000u); }
__device__ __forceinline__ float silu_f(float x) { return x * __builtin_amdgcn_rcpf(1.0f + __builtin_amdgcn_exp2f(-1.4426950408889634f * x)); }
__device__ __forceinline__ float lg2_gamma(int h) { return h == 0 ? -0.04580368961312479f : h == 1 ? -0.02272007650008353f : h == 2 ? -0.011315313227834146f : -0.005646563141142063f; }
constexpr float QSCALE = 0.18033688011112042f;

struct GOrder {
    StaticOrder so; int a_off, o_off, t_off; const int* tile_e;
    __device__ __forceinline__ void init(int ntiles, int N, int G, int c, int a_off_, int o_off_, const int* te, int t_off_) { so.init(ntiles * BM, N, G, c); a_off = a_off_; o_off = o_off_; tile_e = te; t_off = t_off_; }
    __device__ __forceinline__ bool next(int i, Unit& u) const {
        if (!so.next(i, u)) return false;
        const int loc = u.pm; u.am = loc + a_off; u.pm = loc + o_off;
        u.e = tile_e ? (int)__builtin_amdgcn_readfirstlane((int)__hip_atomic_load(tile_e + loc + t_off, __ATOMIC_RELAXED, __HIP_MEMORY_SCOPE_AGENT)) : 0; return true;
    }
    __device__ __forceinline__ void a_ready(const Unit&) const {}
    __device__ __forceinline__ void done(const Unit&) const {}
};

struct EpiInProj {
    static constexpr bool PERM = true, AFTER_DRAIN = false;
    bf16_t* O;
    __device__ __forceinline__ void operator()(const f32x4 (&acc)[2][2][4][2], const Unit& u, int wr, int wc, int fr, int fq) const {
        constexpr int LDC = 2816;
        const int row0 = u.pm * BM + wr * 64 + fr, col0 = u.pn * BM + wc * 32 + 8 * fq, pn = u.pn;
        const int kind = (pn < 2) ? 1 : (pn == 7) ? 2 : (pn == 8) ? 3 : (pn == 10) ? 4 : 0;
        if (kind == 2 || kind == 3) {
            const int i0 = (wc & 1) * 16 + 4 * fq;
            float inv4[4];
#pragma unroll
            for (int jj = 0; jj < 4; ++jj) inv4[jj] = __builtin_amdgcn_exp2f(-(float)(i0 + jj) * 0.42863588321127255f);
            const float lg0 = lg2_gamma(wc >> 1), lg1 = lg2_gamma(2 + (wc >> 1));
#pragma unroll
            for (int ai = 0; ai < 2; ++ai)
#pragma unroll
                for (int m = 0; m < 4; ++m) {
                    const int row = row0 + ai * HALF + m * 16, pos = row & 8191; const float fi = (float)(pos & 127);
                    bf16_t* rowp = O + (size_t)row * LDC + col0;
                    float cs[4], sn[4];
#pragma unroll
                    for (int jj = 0; jj < 4; ++jj) { const float ang = (float)pos * inv4[jj]; float rv = ang * 0.15915494309189535f; rv = rv - __builtin_floorf(rv); cs[jj] = __builtin_amdgcn_cosf(rv); sn[jj] = __builtin_amdgcn_sinf(rv); }
#pragma unroll
                    for (int bj = 0; bj < 2; ++bj) {
                        const float lg = bj ? lg1 : lg0;
                        const float f = (kind == 2) ? __builtin_amdgcn_exp2f(fi * lg) : 0.125f * __builtin_amdgcn_exp2f(-fi * lg);
                        const f32x4 v0 = acc[ai][bj][m][0], v1 = acc[ai][bj][m][1];
                        const float a0 = (v0[0] * cs[0] - v0[1] * sn[0]) * f, b0 = (v0[0] * sn[0] + v0[1] * cs[0]) * f;
                        const float a1 = (v0[2] * cs[1] - v0[3] * sn[1]) * f, b1 = (v0[2] * sn[1] + v0[3] * cs[1]) * f;
                        const float a2 = (v1[0] * cs[2] - v1[1] * sn[2]) * f, b2 = (v1[0] * sn[2] + v1[1] * cs[2]) * f;
                        const float a3 = (v1[2] * cs[3] - v1[3] * sn[3]) * f, b3 = (v1[2] * sn[3] + v1[3] * cs[3]) * f;
                        u32x4 w; w.x = cvt_pk_bf16(a0, b0); w.y = cvt_pk_bf16(a1, b1); w.z = cvt_pk_bf16(a2, b2); w.w = cvt_pk_bf16(a3, b3);
                        *(u32x4*)(rowp + bj * HALF) = w; }
                }
        } else {
            const float sc = (kind == 1) ? QSCALE : 1.0f;
#pragma unroll
            for (int ai = 0; ai < 2; ++ai)
#pragma unroll
                for (int m = 0; m < 4; ++m) { bf16_t* rowp = O + (size_t)(row0 + ai * HALF + m * 16) * LDC + col0;
#pragma unroll
                    for (int bj = 0; bj < 2; ++bj) { f32x4 v0 = acc[ai][bj][m][0] * sc, v1 = acc[ai][bj][m][1] * sc;
                        if (kind == 4) { v0 = (f32x4){silu_f(v0[0]), silu_f(v0[1]), silu_f(v0[2]), silu_f(v0[3])}; v1 = (f32x4){silu_f(v1[0]), silu_f(v1[1]), silu_f(v1[2]), silu_f(v1[3])}; }
                        u32x4 w; w.x = cvt_pk_bf16(v0[0], v0[1]); w.y = cvt_pk_bf16(v0[2], v0[3]); w.z = cvt_pk_bf16(v1[0], v1[1]); w.w = cvt_pk_bf16(v1[2], v1[3]);
                        *(u32x4*)(rowp + bj * HALF) = w; } }
        }
    }
};
struct EpiResid {
    static constexpr bool PERM = true, AFTER_DRAIN = false;
    const bf16_t* X; float* T; float alpha;
    __device__ __forceinline__ void operator()(const f32x4 (&acc)[2][2][4][2], const Unit& u, int wr, int wc, int fr, int fq) const {
        const int row0 = u.pm * BM + wr * 64 + fr, col0 = u.pn * BM + wc * 32 + 8 * fq;
#pragma unroll
        for (int ai = 0; ai < 2; ++ai)
#pragma unroll
            for (int m = 0; m < 4; ++m) { const size_t off = (size_t)(row0 + ai * HALF + m * 16) * 1024 + col0;
#pragma unroll
                for (int bj = 0; bj < 2; ++bj) { const u32x4 xr = *(const u32x4*)(X + off + bj * HALF); const f32x4 v0 = acc[ai][bj][m][0], v1 = acc[ai][bj][m][1];
                    const f32x4 o0 = {alpha * bf_lo(xr.x) + v0[0], alpha * bf_hi(xr.x) + v0[1], alpha * bf_lo(xr.y) + v0[2], alpha * bf_hi(xr.y) + v0[3]};
                    const f32x4 o1 = {alpha * bf_lo(xr.z) + v1[0], alpha * bf_hi(xr.z) + v1[1], alpha * bf_lo(xr.w) + v1[2], alpha * bf_hi(xr.w) + v1[3]};
                    *(f32x4*)(T + off + bj * HALF) = o0; *(f32x4*)(T + off + bj * HALF + 4) = o1; } }
    }
};
struct EpiSwiGLU {
    static constexpr bool PERM = true, AFTER_DRAIN = false;
    bf16_t* H; int ldc;
    __device__ __forceinline__ void operator()(const f32x4 (&acc)[2][2][4][2], const Unit& u, int wr, int wc, int fr, int fq) const {
        const int row0 = u.pm * BM + wr * 64 + fr, col0 = u.pn * HALF + wc * 32 + 8 * fq;
#pragma unroll
        for (int ai = 0; ai < 2; ++ai)
#pragma unroll
            for (int m = 0; m < 4; ++m) { bf16_t* p = H + (size_t)(row0 + ai * HALF + m * 16) * ldc + col0;
                const f32x4 g0 = acc[ai][0][m][0], g1 = acc[ai][0][m][1], u0 = acc[ai][1][m][0], u1 = acc[ai][1][m][1];
                u32x4 w; w.x = cvt_pk_bf16(silu_f(g0[0]) * u0[0], silu_f(g0[1]) * u0[1]); w.y = cvt_pk_bf16(silu_f(g0[2]) * u0[2], silu_f(g0[3]) * u0[3]);
                w.z = cvt_pk_bf16(silu_f(g1[0]) * u1[0], silu_f(g1[1]) * u1[1]); w.w = cvt_pk_bf16(silu_f(g1[2]) * u1[2], silu_f(g1[3]) * u1[3]);
                *(u32x4*)p = w; }
    }
};
struct EpiPlain {
    static constexpr bool PERM = true, AFTER_DRAIN = false;
    bf16_t* O; int ldc;
    __device__ __forceinline__ void operator()(const f32x4 (&acc)[2][2][4][2], const Unit& u, int wr, int wc, int fr, int fq) const {
        const int row0 = u.pm * BM + wr * 64 + fr, col0 = u.pn * BM + wc * 32 + 8 * fq;
#pragma unroll
        for (int ai = 0; ai < 2; ++ai)
#pragma unroll
            for (int m = 0; m < 4; ++m) { bf16_t* rowp = O + (size_t)(row0 + ai * HALF + m * 16) * ldc + col0;
#pragma unroll
                for (int bj = 0; bj < 2; ++bj) { const f32x4 v0 = acc[ai][bj][m][0], v1 = acc[ai][bj][m][1];
                    u32x4 w; w.x = cvt_pk_bf16(v0[0], v0[1]); w.y = cvt_pk_bf16(v0[2], v0[3]); w.z = cvt_pk_bf16(v1[0], v1[1]); w.w = cvt_pk_bf16(v1[2], v1[3]);
                    *(u32x4*)(rowp + bj * HALF) = w; } }
    }
};

template <class Epi, class Sched, bool ALIGN_EPI = false, bool SP2 = false>
__device__ __forceinline__ void gemm_phase(PG8_LAS unsigned char* lds, const Gemm g, const Sched& S, const Epi& E) {
    int tid_ = threadIdx.x; asm volatile("" : "+v"(tid_));
    const int tid = tid_, wid = __builtin_amdgcn_readfirstlane(tid >> 6), lane = tid & 63, wr = wid >> 2, wc = wid & 3, fr = lane & 15, fq = lane >> 4;
    const int K = g.K, nt = K / BK;
    unsigned voffA[2], voffB[2];
#pragma unroll
    for (int i = 0; i < 2; ++i) { int R, C; stage_rc(tid * 16 + i * 8192, R, C); const int Rb = Epi::PERM ? ((R & ~31) + perm32(R & 31)) : R;
        voffA[i] = (unsigned)(R * K + C) * 2u; voffB[i] = (unsigned)(Rb * K + C) * 2u; }
    const size_t kstep = (size_t)(BK * 2);
    const size_t hstep = (size_t)HALF * K * 2;
    const size_t tstep = 2 * hstep;
    const unsigned ldsw = (unsigned)wid * 1024u;
    const int aoff = lds_byte(wr * 64 + fr, fq * 8), boff = lds_byte(wc * 32 + fr, fq * 8);
#define PG8_SA(b, h) (((b) * 2 + (h)) * HTB)
#define PG8_SB(b, h) ((4 + (b) * 2 + (h)) * HTB)
#define PG8_STAGE(bufoff, gbase, voff) do { _Pragma("unroll") for (int _i = 0; _i < 2; ++_i) \
        __builtin_amdgcn_global_load_lds((const unsigned*)((const char*)(gbase) + (voff)[_i]), (PG8_LAS unsigned*)(lds + (bufoff) + ldsw + _i * 8192), 16, 0, 0); } while (0)
#define PG8_LDA(dst, b, h) do { _Pragma("unroll") for (int m = 0; m < 4; ++m) _Pragma("unroll") for (int k = 0; k < 2; ++k) dst[m][k] = *(const PG8_LAS bf16x8*)(lds + PG8_SA(b, h) + aoff + m * 2048 + k * 1024); } while (0)
#define PG8_LDB(dst, b, h) do { _Pragma("unroll") for (int n = 0; n < 2; ++n) _Pragma("unroll") for (int k = 0; k < 2; ++k) dst[n][k] = *(const PG8_LAS bf16x8*)(lds + PG8_SB(b, h) + boff + n * 2048 + k * 1024); } while (0)
#define PG8_MMA(ai, bj, At, Bt) do { __builtin_amdgcn_s_setprio(1); _Pragma("unroll") for (int m = 0; m < 4; ++m) _Pragma("unroll") for (int n = 0; n < 2; ++n) _Pragma("unroll") for (int k = 0; k < 2; ++k) \
        acc[ai][bj][m][n] = __builtin_amdgcn_mfma_f32_16x16x32_bf16(Bt[n][k], At[m][k], acc[ai][bj][m][n], 0, 0, 0); __builtin_amdgcn_s_setprio(0); } while (0)
#define PG8_WAIT_V(n) asm volatile("s_waitcnt vmcnt(" #n ")" ::: "memory")
#define PG8_WAIT_L(n) asm volatile("s_waitcnt lgkmcnt(" #n ")" ::: "memory")
#define PG8_BAR __builtin_amdgcn_s_barrier()
#define PG8_SCHED __builtin_amdgcn_sched_barrier(0)
    Unit cur, nxt; int ui = 0;
    if (!S.next(0, cur)) return;
    f32x4 acc[2][2][4][2];
#pragma unroll
    for (int a = 0; a < 2; ++a)
#pragma unroll
        for (int b = 0; b < 2; ++b)
#pragma unroll
            for (int m = 0; m < 4; ++m)
#pragma unroll
                for (int n = 0; n < 2; ++n) acc[a][b][m][n] = (f32x4){0.f, 0.f, 0.f, 0.f};
    bf16x8 At[4][2], B0[2][2], B1[2][2];
    const char* cA = (const char*)g.A + (size_t)cur.am * tstep; const char* cB = (const char*)g.Bt + (size_t)cur.e * g.bstride + (size_t)cur.pn * tstep;
    S.a_ready(cur);
    if constexpr (SP2) {
        PG8_STAGE(PG8_SB(0, 0), cB, voffB); PG8_STAGE(PG8_SB(0, 1), cB + hstep, voffB); PG8_STAGE(PG8_SA(0, 0), cA, voffA); PG8_STAGE(PG8_SA(0, 1), cA + hstep, voffA);
        if (wr == 1) PG8_BAR;
        PG8_WAIT_V(2); PG8_BAR;
        PG8_STAGE(PG8_SB(1, 0), cB + kstep, voffB); PG8_STAGE(PG8_SA(1, 0), cA + kstep, voffA); PG8_STAGE(PG8_SB(1, 1), cB + hstep + kstep, voffB);
        PG8_WAIT_V(6); PG8_BAR;
    } else {
        PG8_STAGE(PG8_SB(0, 0), cB, voffB); PG8_STAGE(PG8_SA(0, 0), cA, voffA); PG8_STAGE(PG8_SB(0, 1), cB + hstep, voffB); PG8_STAGE(PG8_SA(0, 1), cA + hstep, voffA);
        if (wr == 1) PG8_BAR;
        PG8_WAIT_V(4); PG8_BAR;
        PG8_STAGE(PG8_SB(1, 0), cB + kstep, voffB); PG8_STAGE(PG8_SA(1, 0), cA + kstep, voffA); PG8_STAGE(PG8_SB(1, 1), cB + hstep + kstep, voffB);
        PG8_WAIT_V(6); PG8_BAR;
    }
    for (;;) {
        const bool has_next = S.next(ui + 1, nxt);
        const char* nA = has_next ? (const char*)g.A + (size_t)nxt.am * tstep : cA; const char* nB = has_next ? (const char*)g.Bt + (size_t)nxt.e * g.bstride + (size_t)nxt.pn * tstep : cB;
        for (int t = 0; t < nt; t += 2) {
            const bool last = (t == nt - 2);
            const char* a1 = cA + (size_t)(t + 1) * kstep;
            const char* a2 = last ? nA : cA + (size_t)(t + 2) * kstep; const char* b2 = last ? nB : cB + (size_t)(t + 2) * kstep;
            const char* a3 = a2 + kstep; const char* b3 = b2 + kstep;
            if (last && has_next) S.a_ready(nxt);
            if constexpr (SP2) {
            PG8_LDB(B0, 0, 0); PG8_LDB(B1, 0, 1); PG8_SCHED; PG8_LDA(At, 0, 0); PG8_STAGE(PG8_SA(1, 1), a1 + hstep, voffA);
            PG8_WAIT_V(8); PG8_WAIT_L(0); PG8_BAR; PG8_MMA(0, 0, At, B0); PG8_MMA(0, 1, At, B1); PG8_BAR; PG8_SCHED;
            PG8_LDA(At, 0, 1); PG8_STAGE(PG8_SB(0, 0), b2, voffB); PG8_STAGE(PG8_SB(0, 1), b2 + hstep, voffB); PG8_STAGE(PG8_SA(0, 0), a2, voffA);
            PG8_WAIT_V(8); PG8_WAIT_L(0); PG8_BAR; PG8_MMA(1, 0, At, B0); PG8_MMA(1, 1, At, B1); PG8_BAR; PG8_SCHED;
            PG8_LDB(B0, 1, 0); PG8_LDB(B1, 1, 1); PG8_SCHED; PG8_LDA(At, 1, 0); PG8_STAGE(PG8_SA(0, 1), a2 + hstep, voffA);
            PG8_WAIT_V(8); PG8_WAIT_L(0); PG8_BAR; PG8_MMA(0, 0, At, B0); PG8_MMA(0, 1, At, B1); PG8_BAR; PG8_SCHED;
            PG8_LDA(At, 1, 1); PG8_STAGE(PG8_SB(1, 0), b3, voffB); PG8_STAGE(PG8_SB(1, 1), b3 + hstep, voffB); PG8_STAGE(PG8_SA(1, 0), a3, voffA);
            PG8_WAIT_V(8); PG8_WAIT_L(0); PG8_BAR; PG8_MMA(1, 0, At, B0); PG8_MMA(1, 1, At, B1); PG8_BAR; PG8_SCHED;
            } else {
            PG8_LDB(B0, 0, 0); PG8_SCHED; PG8_LDA(At, 0, 0); PG8_STAGE(PG8_SA(1, 1), a1 + hstep, voffA);
            PG8_WAIT_L(8); PG8_BAR; PG8_WAIT_L(0); PG8_MMA(0, 0, At, B0); PG8_BAR; PG8_SCHED;
            PG8_LDB(B1, 0, 1); PG8_STAGE(PG8_SB(0, 0), b2, voffB);
            PG8_BAR; PG8_WAIT_L(0); PG8_MMA(0, 1, At, B1); PG8_BAR;
            PG8_LDA(At, 0, 1); PG8_STAGE(PG8_SA(0, 0), a2, voffA);
            PG8_BAR; PG8_WAIT_L(0); PG8_MMA(1, 0, At, B0); PG8_BAR; PG8_SCHED;
            PG8_STAGE(PG8_SB(0, 1), b2 + hstep, voffB);
            PG8_WAIT_V(6); PG8_BAR; PG8_MMA(1, 1, At, B1); PG8_BAR;
            PG8_LDB(B0, 1, 0); PG8_SCHED; PG8_LDA(At, 1, 0); PG8_STAGE(PG8_SA(0, 1), a2 + hstep, voffA);
            PG8_WAIT_L(8); PG8_BAR; PG8_WAIT_L(0); PG8_MMA(0, 0, At, B0); PG8_BAR; PG8_SCHED;
            PG8_LDB(B1, 1, 1); PG8_STAGE(PG8_SB(1, 0), b3, voffB);
            PG8_BAR; PG8_WAIT_L(0); PG8_MMA(0, 1, At, B1); PG8_BAR;
            PG8_LDA(At, 1, 1); PG8_STAGE(PG8_SA(1, 0), a3, voffA);
            PG8_BAR; PG8_WAIT_L(0); PG8_MMA(1, 0, At, B0); PG8_BAR; PG8_SCHED;
            PG8_STAGE(PG8_SB(1, 1), b3 + hstep, voffB);
            PG8_WAIT_V(6); PG8_BAR; PG8_MMA(1, 1, At, B1); PG8_BAR;
            }
        }
        if constexpr (ALIGN_EPI) { if (wr == 0) PG8_BAR; }
        if constexpr (!Epi::AFTER_DRAIN) { E(acc, cur, wr, wc, fr, fq); S.done(cur); }
        if (!has_next) break;
#pragma unroll
        for (int a = 0; a < 2; ++a)
#pragma unroll
            for (int b = 0; b < 2; ++b)
#pragma unroll
                for (int m = 0; m < 4; ++m)
#pragma unroll
                    for (int n = 0; n < 2; ++n) acc[a][b][m][n] = (f32x4){0.f, 0.f, 0.f, 0.f};
        cur = nxt; cA = nA; cB = nB; ++ui;
        if constexpr (ALIGN_EPI) { if (wr == 1) PG8_BAR; }
    }
    PG8_WAIT_V(0);
    if constexpr (!ALIGN_EPI) { if (wr == 0) PG8_BAR; }
    PG8_BAR;
    if constexpr (Epi::AFTER_DRAIN) { E.fused(acc, cur, wr, wc, fr, fq, lds, wid, lane); S.done(cur); }
#undef PG8_SA
#undef PG8_SB
#undef PG8_STAGE
#undef PG8_LDA
#undef PG8_LDB
#undef PG8_MMA
#undef PG8_WAIT_V
#undef PG8_WAIT_L
#undef PG8_BAR
#undef PG8_SCHED
}
}
#define GAS __attribute__((address_space(1)))
#define LAS __attribute__((address_space(3)))
typedef unsigned short bf16;
typedef unsigned v4u __attribute__((ext_vector_type(4)));
typedef float f32x4 __attribute__((ext_vector_type(4)));
typedef short bf16x8 __attribute__((ext_vector_type(8)));
typedef GAS unsigned gu32;
typedef GAS unsigned long long gu64;
#define RLX_AGENT __ATOMIC_RELAXED, __HIP_MEMORY_SCOPE_AGENT
#define LDS_WAIT() asm volatile("s_waitcnt lgkmcnt(0)" ::: "memory")
#define VM_WAIT() asm volatile("s_waitcnt vmcnt(0)" ::: "memory")
__device__ __forceinline__ unsigned long long rt() { return __builtin_amdgcn_s_memrealtime(); }
__device__ __forceinline__ unsigned f2bf(float f) { unsigned u = __builtin_bit_cast(unsigned, f); return (u + 0x7fffu + ((u >> 16) & 1u)) >> 16; }
__device__ __forceinline__ unsigned pk2(float lo, float hi) { return f2bf(lo) | (f2bf(hi) << 16); }

#define XB_TMO      128
#define XB_XCNT(j)  (256  + 64 * (j))
#define XB_XSUB(j)  (1280 + 64 * (j))
#define XB_XGEN(j)  (2304 + 64 * (j))
#define XB_TOP      3328
#define XB_TOPGEN   3392
#define XCD_BAR_WORDS 3456
#define XB_SPIN_CAP (1u << 22)

__device__ __forceinline__ unsigned xb_ld(unsigned* p)              { return __hip_atomic_load(p, __ATOMIC_RELAXED, __HIP_MEMORY_SCOPE_AGENT); }
__device__ __forceinline__ unsigned xb_add(unsigned* p, unsigned v) { return __hip_atomic_fetch_add(p, v, __ATOMIC_RELAXED, __HIP_MEMORY_SCOPE_AGENT); }
__device__ __forceinline__ unsigned xb_xcc_id() { return (unsigned)__builtin_amdgcn_s_getreg((3 << 11) | 20) & 0xFu; }
#define XB_SPIN(cond, bar) do { unsigned _sp = 0; while (cond) { __builtin_amdgcn_s_sleep(1); \
    if ((++_sp & 255u) == 0u) { if (xb_ld(&(bar)[XB_TMO])) break; if (_sp > XB_SPIN_CAP) { atomicAdd(&(bar)[XB_TMO], 1u); break; } } } } while (0)

struct XcdBarrier {
    unsigned* bar; unsigned x;
    volatile LAS unsigned* st;
};

__device__ __forceinline__ XcdBarrier xcd_barrier_post(unsigned* bar, volatile LAS unsigned* st) {
    XcdBarrier b; b.bar = bar; b.x = xb_xcc_id(); b.st = st;
    if (threadIdx.x == 0) (void)xb_add(&bar[XB_XCNT(b.x)], 1u);
    return b;
}
__device__ __forceinline__ void xcd_barrier_complete(unsigned* bar, unsigned x, unsigned& nloc, unsigned& nx) {
    const unsigned G = gridDim.x * gridDim.y * gridDim.z;
    unsigned sum, cnt, mine, sp = 0u;
    for (;;) {
        sum = 0u; cnt = 0u; mine = 0u;
#pragma unroll
        for (unsigned j = 0; j < 16; ++j) { const unsigned c = xb_ld(&bar[XB_XCNT(j)]); sum += c; cnt += (c > 0u) ? 1u : 0u; mine = (j == x) ? c : mine; }
        if (sum == G) break;
        __builtin_amdgcn_s_sleep(1);
        if ((++sp & 255u) == 0u) { if (xb_ld(&bar[XB_TMO])) break; if (sp > XB_SPIN_CAP) { atomicAdd(&bar[XB_TMO], 1u); break; } }
    }
    nloc = mine > 0u ? mine : 1u; nx = cnt > 0u ? cnt : 1u;
}

__device__ __forceinline__ void xcd_barrier(const XcdBarrier& b) {
    asm volatile("s_waitcnt vmcnt(0)" ::: "memory");
    __syncthreads();
    if (threadIdx.x == 0) {
        unsigned* bar = b.bar;
        __builtin_amdgcn_s_waitcnt(0);
        unsigned nloc = b.st[0], nx = b.st[1];
        if (nloc == 0u) { xcd_barrier_complete(bar, b.x, nloc, nx); b.st[0] = nloc; b.st[1] = nx; }
        const unsigned old = xb_add(&bar[XB_XSUB(b.x)], 1u);
        const unsigned gen = old / nloc;
        if (old + 1u == (gen + 1u) * nloc) {
            __builtin_amdgcn_fence(__ATOMIC_RELEASE, "agent");
            asm volatile("s_waitcnt vmcnt(0)" ::: "memory");
            const unsigned og = xb_add(&bar[XB_TOP], 1u);
            const unsigned tg = og / nx;
            if (og + 1u == (tg + 1u) * nx) xb_add(&bar[XB_TOPGEN], 1u);
            else XB_SPIN(xb_ld(&bar[XB_TOPGEN]) == tg, bar);
            __builtin_amdgcn_fence(__ATOMIC_ACQUIRE, "agent");
            xb_add(&bar[XB_XGEN(b.x)], 1u);
            asm volatile("s_waitcnt vmcnt(0)" ::: "memory");
        } else {
            XB_SPIN(xb_ld(&bar[XB_XGEN(b.x)]) == gen, bar);
            __builtin_amdgcn_fence(__ATOMIC_ACQUIRE, "agent");
            asm volatile("s_waitcnt vmcnt(0)" ::: "memory");
        }
    }
    __syncthreads();
}

constexpr int NWAVES = 8, NTHR = NWAVES * 64;
constexpr int BATCH = 8, SEQ = 8192, DM = 1024, MROWS = BATCH * SEQ;
constexpr int INW = 2816, FFD = 2816, NEXP = 8, EDIM = 3584, DEPTH = 2;
constexpr int PC_Q = 0, PC_K = 512, PC_V = 1024, PC_POOL = 1536, PC_RQ = 1792, PC_RK = 2048, PC_RV = 2304, PC_RG = 2560;
constexpr float LN_EPS = 1e-5f, NORM_EPS = 1e-6f, ALPHA = 1.4142135623730951f, LOG2E = 1.4426950408889634f;
constexpr int NQ = 4;
constexpr int MAXTILES = (MROWS * 2) / 256 + NEXP;

constexpr size_t MiB = 1u << 20;
constexpr size_t WS_CTL = 0, CTL_ZERO_BYTES = 1 * MiB;
constexpr size_t WS_RE = 1 * MiB;
constexpr size_t WS_RG = WS_RE + 512 * 1024;
constexpr size_t WS_RS = WS_RG + 512 * 1024;
constexpr size_t WS_BC = WS_RS + 512 * 1024;
constexpr size_t WS_MI = WS_BC + 16 * 1024;
constexpr size_t WS_W = 8 * MiB;
constexpr size_t WS_WIN = WS_W;
constexpr size_t WS_WOUT = WS_WIN + 2 * (size_t)INW * DM * 2;
constexpr size_t WS_WGU = WS_WOUT + 2 * (size_t)DM * DM * 2;
constexpr size_t WS_WD = WS_WGU + 2 * (size_t)FFD * DM * 2;
constexpr size_t WS_MGU = WS_WD + (size_t)FFD * DM * 2;
constexpr size_t WS_MD = WS_MGU + (size_t)NEXP * 2 * EDIM * DM * 2;
constexpr size_t WS_WEND = WS_MD + (size_t)NEXP * EDIM * DM * 2;
constexpr size_t WS_XB = 208 * MiB;
constexpr size_t WS_Y = 336 * MiB;
constexpr size_t WS_P = 464 * MiB;
constexpr size_t WS_O = 816 * MiB;
constexpr size_t WS_END = 944 * MiB;
constexpr size_t WS_HQ = WS_XB;
constexpr size_t WS_XG = WS_P;
static_assert(WS_WEND <= WS_XB, "weights fit");
static_assert((size_t)(MAXTILES / NQ + 1) * 256 * EDIM * 2 <= WS_P - WS_XB, "hidden chunk fits");
static_assert((size_t)MAXTILES * 256 * DM * 2 <= WS_O - WS_P, "slot rows fit");
constexpr int CW_TMO = 0, CW_BAR = 4096;

constexpr int RING_OFF = 0, RING_BYTES = 131072;
constexpr int LDSCTL_OFF = RING_BYTES, MISC_OFF = LDSCTL_OFF + 320;
constexpr int LDS_BYTES = 147456;


struct Frame {
    LAS unsigned char* lds;
    volatile LAS unsigned* MISC;
    gu32* ctl;
    int vcu, G;
    float* out; unsigned char* ws;
};
__device__ __forceinline__ const float* inp(int k) { const __attribute__((address_space(4))) unsigned char* ka = (const __attribute__((address_space(4))) unsigned char*)__builtin_amdgcn_kernarg_segment_ptr(); asm volatile("" : "+s"(ka)); return *(const float* const __attribute__((address_space(4)))*)(ka + 8 * k); }
#define LANE_DECL int tid = threadIdx.x; asm volatile("" : "+v"(tid)); const int lane = tid & 63, wave = __builtin_amdgcn_readfirstlane(tid >> 6); (void)lane; (void)wave
__device__ __forceinline__ float wave_sum(float v) {
#pragma unroll
    for (int o = 1; o < 64; o <<= 1) v += __shfl_xor(v, o);
    return v;
}
__device__ __forceinline__ float bflo(unsigned w) { return __uint_as_float(w << 16); }
__device__ __forceinline__ float bfhi(unsigned w) { return __uint_as_float(w & 0xffff0000u); }
__device__ __forceinline__ float bf2f(bf16 h) { return __uint_as_float((unsigned)h << 16); }

template <class SrcFn>
__device__ __forceinline__ void p0_item(int K, int nblk, size_t ldn, bf16* WT, LAS float* scr, int item, int lane, const SrcFn& src) {
    const int kb = item / nblk, nb = item % nblk, k0 = 64 * kb, n0 = 32 * nb;
    const float* colp = src(n0 + (lane & 31));
#pragma unroll 8
    for (int i = 0; i < 32; ++i) { const int kk = 2 * i + (lane >> 5); scr[kk * 33 + (lane & 31)] = colp[(size_t)(k0 + kk) * ldn]; }
    LDS_WAIT(); asm volatile("" ::: "memory");
    const int c = lane & 7;
#pragma unroll
    for (int j = 0; j < 4; ++j) { const int n = (lane >> 3) + 8 * j; const LAS float* s = scr + (8 * c) * 33 + n;
        v4u o; o.x = pk2(s[0 * 33], s[1 * 33]); o.y = pk2(s[2 * 33], s[3 * 33]); o.z = pk2(s[4 * 33], s[5 * 33]); o.w = pk2(s[6 * 33], s[7 * 33]);
        *(GAS v4u*)(WT + (size_t)(n0 + n) * K + k0 + 8 * c) = o; }
    LDS_WAIT(); asm volatile("" ::: "memory");
}
__device__ __forceinline__ void p0_prologue(Frame& F) {
    LANE_DECL;
    LAS float* scr = (LAS float*)(F.lds + RING_OFF + wave * 16384);
    const int gw = F.vcu * NWAVES + wave, NGW = F.G * NWAVES;
    unsigned char* ws = F.ws;
    constexpr int I_IN = (DM / 64) * (INW / 32), I_OUT = (DM / 64) * (DM / 32), I_GU = (DM / 64) * (2 * FFD / 32), I_D = (FFD / 64) * (DM / 32);
    constexpr int I_MGU = (DM / 64) * (2 * EDIM / 32), I_MD = (EDIM / 64) * (DM / 32);
    constexpr int NITEMS = 2 * I_IN + 2 * I_OUT + I_GU + I_D + NEXP * I_MGU + NEXP * I_MD;
    for (int it = gw; it < NITEMS; it += NGW) {
        int r = it;
        if (r < 2 * I_IN) { const int l = r / I_IN; r -= l * I_IN; const float* W = inp(2) + (size_t)l * DM * INW;
            const int nb = r % (INW / 32);
            if (nb >= PC_POOL / 32 && nb < PC_RQ / 32) continue;
            p0_item(DM, INW / 32, INW, (bf16*)(ws + WS_WIN) + (size_t)l * INW * DM, scr, r, lane, [&](int n) -> const float* {
                if (n >= PC_RQ && n < PC_RV) { const int p = (n - PC_RQ) & 63; return W + (n - p) + (p >> 1) + 32 * (p & 1); }
                return W + n; });
            continue; }
        r -= 2 * I_IN;
        if (r < 2 * I_OUT) { const int l = r / I_OUT; r -= l * I_OUT; const float* W = inp(8) + (size_t)l * DM * DM;
            p0_item(DM, DM / 32, DM, (bf16*)(ws + WS_WOUT) + (size_t)l * DM * DM, scr, r, lane, [&](int n) -> const float* { return W + n; }); continue; }
        r -= 2 * I_OUT;
        if (r < I_GU) { const float* Wg = inp(13); const float* Wu = inp(14);
            p0_item(DM, 2 * FFD / 32, FFD, (bf16*)(ws + WS_WGU), scr, r, lane, [&](int n) -> const float* { const int pn = n >> 8, hb = (n >> 7) & 1, j = n & 127; return (hb ? Wu : Wg) + pn * 128 + j; }); continue; }
        r -= I_GU;
        if (r < I_D) { const float* W = inp(15);
            p0_item(FFD, DM / 32, DM, (bf16*)(ws + WS_WD), scr, r, lane, [&](int n) -> const float* { return W + n; }); continue; }
        r -= I_D;
        if (r < NEXP * I_MGU) { const int e = r / I_MGU; r -= e * I_MGU; const float* Wg = inp(17) + (size_t)e * DM * EDIM; const float* Wu = inp(18) + (size_t)e * DM * EDIM;
            p0_item(DM, 2 * EDIM / 32, EDIM, (bf16*)(ws + WS_MGU) + (size_t)e * 2 * EDIM * DM, scr, r, lane, [&](int n) -> const float* { const int pn = n >> 8, hb = (n >> 7) & 1, j = n & 127; return (hb ? Wu : Wg) + pn * 128 + j; }); continue; }
        r -= NEXP * I_MGU;
        { const int e = r / I_MD; r -= e * I_MD; const float* W = inp(19) + (size_t)e * EDIM * DM;
            p0_item(EDIM, DM / 32, DM, (bf16*)(ws + WS_MD) + (size_t)e * DM * EDIM, scr, r, lane, [&](int n) -> const float* { return W + n; }); }
    }
    const int gt = F.vcu * NTHR + tid, NT = F.G * NTHR;
    for (int o = gt; o < DEPTH * 256 * DM; o += NT) {
        const int l = o / (256 * DM), n = (o / DM) & 255, k = o & (DM - 1), g = n >> 6, d = n & 63;
        const float* wr = inp(2) + (size_t)l * DM * INW + (size_t)k * INW + PC_POOL + g * 64;
        const float* pw = inp(5) + (size_t)l * 4 * 64 * 64 + (size_t)g * 64 * 64 + d;
        float s = 0.f;
#pragma unroll 8
        for (int c = 0; c < 64; ++c) s += wr[c] * pw[c * 64];
        ((bf16*)(ws + WS_WIN))[(size_t)l * INW * DM + (size_t)(PC_POOL + n) * DM + k] = (bf16)f2bf(s);
    }
    { const GAS f32x4* x4 = (const GAS f32x4*)inp(0); GAS v4u* xb = (GAS v4u*)(ws + WS_XB);
      for (int i = gt; i < MROWS * DM / 8; i += NT) { const f32x4 a = x4[2 * i], b = x4[2 * i + 1]; v4u o; o.x = pk2(a.x, a.y); o.y = pk2(a.z, a.w); o.z = pk2(b.x, b.y); o.w = pk2(b.z, b.w); xb[i] = o; } }
}

__device__ __forceinline__ void ln_stats(f32x4 (&v)[4], float& mean, float& rstd) {
    float s = 0.f;
#pragma unroll
    for (int j = 0; j < 4; ++j) s += (v[j].x + v[j].y) + (v[j].z + v[j].w);
    mean = wave_sum(s) * (1.f / DM); float s2 = 0.f;
#pragma unroll
    for (int j = 0; j < 4; ++j) { v[j] = v[j] - mean; s2 += (v[j].x * v[j].x + v[j].y * v[j].y) + (v[j].z * v[j].z + v[j].w * v[j].w); }
    rstd = 1.f / sqrtf(wave_sum(s2) * (1.f / DM) + LN_EPS);
}
__device__ __forceinline__ void ln_affine(f32x4 (&v)[4], float rstd, const float* g, const float* b, int lane) {
#pragma unroll
    for (int j = 0; j < 4; ++j) { const f32x4 gg = *(const f32x4*)(g + 4 * lane + 256 * j), bb = *(const f32x4*)(b + 4 * lane + 256 * j); v[j] = v[j] * rstd * gg + bb; }
}
__device__ __forceinline__ void store_row_bf16(const f32x4 (&v)[4], bf16* orow, int lane) {
    GAS unsigned long long* o8 = (GAS unsigned long long*)orow + lane;
#pragma unroll
    for (int j = 0; j < 4; ++j) o8[64 * j] = (unsigned long long)pk2(v[j].x, v[j].y) | ((unsigned long long)pk2(v[j].z, v[j].w) << 32);
}

template <bool ROUTER>
__device__ __forceinline__ void ln1_phase(Frame& F, int l) {
    LANE_DECL;
    const float* T = F.out; bf16* X1 = (bf16*)(F.ws + WS_O);
    const float* g = inp(9) + l * DM; const float* b = inp(10) + l * DM;
    LAS int* hist = (LAS int*)(F.lds + RING_OFF);
    for (int blk = F.vcu; blk < MROWS / 256; blk += F.G) {
        if (ROUTER) { if (tid < 8) hist[tid] = 0; __syncthreads(); }
        for (int i = 0; i < 32; ++i) {
            const int row = blk * 256 + wave * 32 + i;
            const GAS f32x4* tr = (const GAS f32x4*)(T + (size_t)row * DM) + lane;
            f32x4 v[4];
#pragma unroll
            for (int j = 0; j < 4; ++j) v[j] = tr[64 * j];
            float mean, rstd; ln_stats(v, mean, rstd); ln_affine(v, rstd, g, b, lane);
            store_row_bf16(v, X1 + (size_t)row * DM, lane);
            if (ROUTER) {
                const float* rw = inp(16);
                float lg[8];
#pragma unroll
                for (int e = 0; e < 8; ++e) lg[e] = 0.f;
#pragma unroll
                for (int j = 0; j < 4; ++j)
#pragma unroll
                    for (int q = 0; q < 4; ++q) { const int k = 4 * lane + 256 * j + q; const f32x4 r0 = *(const f32x4*)(rw + k * 8), r1 = *(const f32x4*)(rw + k * 8 + 4); const float xv = v[j][q];
                        lg[0] += xv * r0.x; lg[1] += xv * r0.y; lg[2] += xv * r0.z; lg[3] += xv * r0.w; lg[4] += xv * r1.x; lg[5] += xv * r1.y; lg[6] += xv * r1.z; lg[7] += xv * r1.w; }
#pragma unroll
                for (int e = 0; e < 8; ++e) lg[e] = wave_sum(lg[e]);
                int e1 = 0; float v1 = lg[0];
#pragma unroll
                for (int e = 1; e < 8; ++e) if (lg[e] > v1) { v1 = lg[e]; e1 = e; }
                int e2 = -1; float v2 = -INFINITY;
#pragma unroll
                for (int e = 0; e < 8; ++e) if (e != e1 && lg[e] > v2) { v2 = lg[e]; e2 = e; }
                const float g1 = 1.f / (1.f + __expf(v2 - v1)), g2 = 1.f - g1;
                if (lane == 0) {
                    int* re = (int*)(F.ws + WS_RE); float* rg = (float*)(F.ws + WS_RG);
                    re[2 * row] = e1; re[2 * row + 1] = e2; rg[2 * row] = g1; rg[2 * row + 1] = g2;
                    atomicAdd((int*)&hist[e1], 1); atomicAdd((int*)&hist[e2], 1);
                }
            }
        }
        if (ROUTER) { __syncthreads(); if (tid < 8) ((int*)(F.ws + WS_BC))[blk * 8 + tid] = hist[tid]; __syncthreads(); }
    }
}
__device__ __forceinline__ void ln2_phase(Frame& F, int l) {
    LANE_DECL;
    const float* T = F.out; bf16* XB = (bf16*)(F.ws + WS_XB);
    const float* g = inp(11) + l * DM; const float* b = inp(12) + l * DM;
    const int gw = F.vcu * NWAVES + wave, NGW = F.G * NWAVES;
    for (int row = gw; row < MROWS; row += NGW) {
        const GAS f32x4* tr = (const GAS f32x4*)(T + (size_t)row * DM) + lane;
        f32x4 v[4];
#pragma unroll
        for (int j = 0; j < 4; ++j) v[j] = tr[64 * j];
        float mean, rstd; ln_stats(v, mean, rstd); ln_affine(v, rstd, g, b, lane);
        store_row_bf16(v, XB + (size_t)row * DM, lane);
    }
}

__device__ __forceinline__ void route_phase(Frame& F) {
    LANE_DECL;
    LAS int* cnts = (LAS int*)(F.lds + RING_OFF);
    LAS int* tot = cnts + 2048; LAS int* offp = tot + 8; LAS int* base = offp + 8; LAS int* wcnt = base + 8; LAS int* ntl = wcnt + 64;
    const int* bc = (const int*)(F.ws + WS_BC); const int* re = (const int*)(F.ws + WS_RE);
    int* rs = (int*)(F.ws + WS_RS); int* mi = (int*)(F.ws + WS_MI);
    const bf16* X1 = (const bf16*)(F.ws + WS_O); bf16* XG = (bf16*)(F.ws + WS_XG);
    for (int blk = F.vcu; blk < MROWS / 256; blk += F.G) {
        __syncthreads();
        for (int i = tid; i < 2048; i += NTHR) cnts[i] = bc[i];
        __syncthreads();
        if (tid < 8) { int run = 0, mine = 0; for (int w = 0; w < 256; ++w) { if (w == blk) mine = run; run += cnts[w * 8 + tid]; } tot[tid] = run; base[tid] = mine; }
        __syncthreads();
        if (tid == 0) { int off = 0; for (int e = 0; e < 8; ++e) { offp[e] = off; off += (tot[e] + 255) & ~255; } ntl[0] = off >> 8; }
        __syncthreads();
        const int a = tid, tok = blk * 256 + (a >> 1), k = a & 1;
        const int e = re[2 * tok + k];
        int rk = 0;
#pragma unroll
        for (int ee = 0; ee < 8; ++ee) { const unsigned long long mask = __ballot(e == ee); if (e == ee) rk = __popcll(mask & ((1ull << lane) - 1ull)); if (lane == 0) wcnt[wave * 8 + ee] = __popcll(mask); }
        __syncthreads();
        int wb = 0;
        for (int w = 0; w < wave; ++w) wb += wcnt[w * 8 + e];
        const int slot = offp[e] + base[e] + wb + rk;
        rs[2 * tok + k] = slot;
        for (int i = 0; i < 64; ++i) { const int s = __shfl(slot, i), tk = __shfl(tok, i);
            const GAS v4u* src = (const GAS v4u*)(X1 + (size_t)tk * DM) + 2 * lane; GAS v4u* dst = (GAS v4u*)(XG + (size_t)s * DM) + 2 * lane;
            const v4u x0 = src[0], x1 = src[1]; dst[0] = x0; dst[1] = x1; }
        for (int ee = 0; ee < 8; ++ee) { const int lo = offp[ee] + tot[ee], hi = offp[ee] + ((tot[ee] + 255) & ~255);
            for (int s = lo + blk; s < hi; s += MROWS / 256) ((GAS unsigned*)(XG + (size_t)s * DM))[tid] = 0u; }
        if (blk == 0) { const int ntiles = ntl[0];
            if (tid == 0) mi[0] = ntiles;
            for (int t = tid; t < ntiles; t += NTHR) { int ee = 0;
#pragma unroll
                for (int x = 1; x < 8; ++x) if (t * 256 >= offp[x]) ee = x;
                mi[16 + t] = ee; } }
    }
}

__device__ __forceinline__ void moe_out_phase(Frame& F, int l) {
    LANE_DECL;
    const bf16* X1 = (const bf16*)(F.ws + WS_O); const bf16* YB = (const bf16*)(F.ws + WS_XG);
    const int* rs = (const int*)(F.ws + WS_RS); const float* rg = (const float*)(F.ws + WS_RG);
    const float* g = inp(11) + l * DM; const float* b = inp(12) + l * DM;
    const int gw = F.vcu * NWAVES + wave, NGW = F.G * NWAVES;
    for (int row = gw; row < MROWS; row += NGW) {
        const int s1 = rs[2 * row], s2 = rs[2 * row + 1]; const float g1 = rg[2 * row], g2 = rg[2 * row + 1];
        const GAS unsigned long long* xr = (const GAS unsigned long long*)(X1 + (size_t)row * DM) + lane;
        const GAS unsigned long long* y1 = (const GAS unsigned long long*)(YB + (size_t)s1 * DM) + lane;
        const GAS unsigned long long* y2 = (const GAS unsigned long long*)(YB + (size_t)s2 * DM) + lane;
        f32x4 v[4];
#pragma unroll
        for (int j = 0; j < 4; ++j) { const unsigned long long a = xr[64 * j], p = y1[64 * j], q = y2[64 * j];
            const unsigned a0 = (unsigned)a, a1 = (unsigned)(a >> 32), p0 = (unsigned)p, p1 = (unsigned)(p >> 32), q0 = (unsigned)q, q1 = (unsigned)(q >> 32);
            v[j].x = ALPHA * bflo(a0) + (g1 * bflo(p0) + g2 * bflo(q0)); v[j].y = ALPHA * bfhi(a0) + (g1 * bfhi(p0) + g2 * bfhi(q0));
            v[j].z = ALPHA * bflo(a1) + (g1 * bflo(p1) + g2 * bflo(q1)); v[j].w = ALPHA * bfhi(a1) + (g1 * bfhi(p1) + g2 * bfhi(q1)); }
        float mean, rstd; ln_stats(v, mean, rstd); ln_affine(v, rstd, g, b, lane);
        GAS f32x4* o = (GAS f32x4*)(F.out + (size_t)row * DM) + lane;
#pragma unroll
        for (int j = 0; j < 4; ++j) o[64 * j] = v[j];
    }
}

__device__ __forceinline__ float lam_init_of(int l) { return l == 0 ? 0.2f : 0.35550906759096934f; }
__device__ __forceinline__ float lambda_of(int l, int lane) {
    const float* dl = inp(3) + l * 256; const int ln = lane;
    const float a = wave_sum(dl[ln] * dl[64 + ln]), b = wave_sum(dl[128 + ln] * dl[192 + ln]);
    return __expf(a) - __expf(b) + lam_init_of(l);
}
__device__ __forceinline__ void combine_phase(Frame& F, int l) {
    LANE_DECL;
    const bf16* O = (const bf16*)(F.ws + WS_O); const bf16* P = (const bf16*)(F.ws + WS_P); bf16* Y = (bf16*)(F.ws + WS_Y);
    const float lam = lambda_of(l, lane), post = 1.0f - lam_init_of(l);
    const float* sg = inp(4) + l * 128; const float* psc = inp(6) + l * 256;
    const float sg0 = sg[2 * lane], sg1 = sg[2 * lane + 1];
    const f32x4 ps = *(const f32x4*)(psc + 4 * lane);
    const int grp = lane >> 4, win = 2 << grp;
    const int gw = F.vcu * NWAVES + wave, NGW = F.G * NWAVES;
    for (int row = gw; row < MROWS; row += NGW) {
        const GAS unsigned* orow = (const GAS unsigned*)(O + (size_t)row * DM); GAS unsigned* yrow = (GAS unsigned*)(Y + (size_t)row * DM);
#pragma unroll
        for (int h = 0; h < 4; ++h) { const unsigned w0 = orow[h * 64 + lane], w1 = orow[256 + h * 64 + lane];
            const float d0 = bflo(w0) - lam * bflo(w1), d1 = bfhi(w0) - lam * bfhi(w1);
            const float ss = wave_sum(d0 * d0 + d1 * d1); const float r = post / sqrtf(ss * (1.f / 128.f) + NORM_EPS);
            yrow[h * 64 + lane] = pk2(d0 * r * sg0, d1 * r * sg1); }
        const int t = row & (SEQ - 1); const int cnt = (t + 1 < win) ? t + 1 : win;
        f32x4 acc = {0.f, 0.f, 0.f, 0.f}, self = {0.f, 0.f, 0.f, 0.f};
        for (int j = 0; j < 16; ++j) { if (j < cnt) { const unsigned long long w = *((const GAS unsigned long long*)(P + (size_t)(row - j) * INW + PC_POOL) + lane);
                const f32x4 x = {bflo((unsigned)w), bfhi((unsigned)w), bflo((unsigned)(w >> 32)), bfhi((unsigned)(w >> 32))}; acc = acc + x; if (j == 0) self = x; } }
        const float ic = 1.0f / (float)cnt; const f32x4 o = (acc * ic - self) * ps;
        *((GAS unsigned long long*)(Y + (size_t)row * DM + 512) + lane) = (unsigned long long)pk2(o.x, o.y) | ((unsigned long long)pk2(o.z, o.w) << 32);
    }
}

__device__ __forceinline__ int t5_bucket(int n) {
    if (n < 16) return n;
    const float v = (__log2f((float)n) - 4.0f) * (16.0f / 3.0f);
    const int b = 16 + (int)v; return b < 31 ? b : 31;
}
__device__ __forceinline__ void attn_naive_unit(Frame& F, int b, int h, int qb) {
    LANE_DECL;
    constexpr int LP = 68;
    LAS float* Qs = (LAS float*)(F.lds + RING_OFF);
    LAS float* Ks = Qs + 2 * 64 * LP;
    LAS float* Vs = Ks + 2 * 64 * LP;
    LAS float* Ps = Vs + 64 * 128;
    LAS float* LUT = Ps + 64 * LP;
    const bf16* P = (const bf16*)(F.ws + WS_P); bf16* O = (bf16*)(F.ws + WS_O);
    const int t = tid, r = t >> 3, c = t & 7;
    const size_t rowbase = (size_t)b * SEQ; const int r0 = qb * 64;
    __syncthreads();
    if (t < 256) { const int dist = t >> 1, m = t & 1; LUT[t] = inp(1)[t5_bucket(dist) * 8 + h * 2 + m] * LOG2E; }
#pragma unroll
    for (int j = 0; j < 2; ++j) { const int ci = t + 512 * j, m = ci >> 9, rr = (ci >> 3) & 63, c8 = ci & 7;
        const v4u w = *(const GAS v4u*)(P + (rowbase + r0 + rr) * INW + PC_Q + (2 * h + m) * 64 + c8 * 8);
        LAS float* d = Qs + (m * 64 + rr) * LP + c8 * 8;
        d[0] = bflo(w.x); d[1] = bfhi(w.x); d[2] = bflo(w.y); d[3] = bfhi(w.y); d[4] = bflo(w.z); d[5] = bfhi(w.z); d[6] = bflo(w.w); d[7] = bfhi(w.w); }
    float mx[2] = {-INFINITY, -INFINITY}, ls[2] = {0.f, 0.f};
    float o[2][16];
#pragma unroll
    for (int m = 0; m < 2; ++m)
#pragma unroll
        for (int e = 0; e < 16; ++e) o[m][e] = 0.f;
    for (int kt = 0; kt <= qb; ++kt) {
        __syncthreads();
#pragma unroll
        for (int j = 0; j < 2; ++j) { const int ci = t + 512 * j, m = ci >> 9, rr = (ci >> 3) & 63, c8 = ci & 7;
            const v4u w = *(const GAS v4u*)(P + (rowbase + kt * 64 + rr) * INW + PC_K + (2 * h + m) * 64 + c8 * 8);
            LAS float* d = Ks + (m * 64 + rr) * LP + c8 * 8;
            d[0] = bflo(w.x); d[1] = bfhi(w.x); d[2] = bflo(w.y); d[3] = bfhi(w.y); d[4] = bflo(w.z); d[5] = bfhi(w.z); d[6] = bflo(w.w); d[7] = bfhi(w.w); }
#pragma unroll
        for (int j = 0; j < 2; ++j) { const int ci = t + 512 * j, rr = ci >> 4, c8 = ci & 15;
            const v4u w = *(const GAS v4u*)(P + (rowbase + kt * 64 + rr) * INW + PC_V + h * 128 + c8 * 8);
            LAS float* d = Vs + rr * 128 + c8 * 8;
            d[0] = bflo(w.x); d[1] = bfhi(w.x); d[2] = bflo(w.y); d[3] = bfhi(w.y); d[4] = bflo(w.z); d[5] = bfhi(w.z); d[6] = bflo(w.w); d[7] = bfhi(w.w); }
        __syncthreads();
#pragma unroll
        for (int m = 0; m < 2; ++m) {
            float s[8];
#pragma unroll
            for (int j = 0; j < 8; ++j) s[j] = 0.f;
            const LAS float* qp = Qs + (m * 64 + r) * LP; const LAS float* kp = Ks + (m * 64 + c) * LP;
#pragma unroll 4
            for (int d4 = 0; d4 < 16; ++d4) { const f32x4 q = *(const LAS f32x4*)(qp + 4 * d4);
#pragma unroll
                for (int j = 0; j < 8; ++j) { const f32x4 k = *(const LAS f32x4*)(kp + 8 * j * LP + 4 * d4); s[j] += (q.x * k.x + q.y * k.y) + (q.z * k.z + q.w * k.w); } }
            float tmax = -INFINITY;
#pragma unroll
            for (int j = 0; j < 8; ++j) { const int dist = (r0 + r) - (kt * 64 + c + 8 * j); s[j] = dist >= 0 ? s[j] + LUT[(dist < 127 ? dist : 127) * 2 + m] : -INFINITY; tmax = fmaxf(tmax, s[j]); }
            tmax = fmaxf(tmax, __shfl_xor(tmax, 1)); tmax = fmaxf(tmax, __shfl_xor(tmax, 2)); tmax = fmaxf(tmax, __shfl_xor(tmax, 4));
            const float mnew = fmaxf(mx[m], tmax), alpha = __builtin_amdgcn_exp2f(mx[m] - mnew);
            float psum = 0.f;
#pragma unroll
            for (int j = 0; j < 8; ++j) { const float p = __builtin_amdgcn_exp2f(s[j] - mnew); psum += p; Ps[r * LP + c + 8 * j] = p; }
            ls[m] = ls[m] * alpha + psum; mx[m] = mnew;
#pragma unroll
            for (int e = 0; e < 16; ++e) o[m][e] *= alpha;
            __syncthreads();
            const LAS float* pp = Ps + r * LP; const LAS float* vp = Vs + c * 16;
#pragma unroll 4
            for (int kk = 0; kk < 64; ++kk) { const float pv = pp[kk];
#pragma unroll
                for (int e4 = 0; e4 < 4; ++e4) { const f32x4 v = *(const LAS f32x4*)(vp + kk * 128 + 4 * e4);
                    o[m][4 * e4] += pv * v.x; o[m][4 * e4 + 1] += pv * v.y; o[m][4 * e4 + 2] += pv * v.z; o[m][4 * e4 + 3] += pv * v.w; } }
            __syncthreads();
        }
    }
#pragma unroll
    for (int m = 0; m < 2; ++m) { float l = ls[m]; l += __shfl_xor(l, 1); l += __shfl_xor(l, 2); l += __shfl_xor(l, 4); const float il = 1.0f / l;
        v4u w0, w1;
        w0.x = pk2(o[m][0] * il, o[m][1] * il); w0.y = pk2(o[m][2] * il, o[m][3] * il); w0.z = pk2(o[m][4] * il, o[m][5] * il); w0.w = pk2(o[m][6] * il, o[m][7] * il);
        w1.x = pk2(o[m][8] * il, o[m][9] * il); w1.y = pk2(o[m][10] * il, o[m][11] * il); w1.z = pk2(o[m][12] * il, o[m][13] * il); w1.w = pk2(o[m][14] * il, o[m][15] * il);
        GAS v4u* dst = (GAS v4u*)(O + (rowbase + r0 + r) * DM + m * 512 + h * 128 + c * 16);
        dst[0] = w0; dst[1] = w1; }
}
__device__ __forceinline__ void ret_naive_unit(Frame& F, int l, int b, int h) {
    LANE_DECL;
    LAS float* qs = (LAS float*)(F.lds + RING_OFF);
    LAS float* ks = qs + 32 * 64; LAS float* vs = ks + 32 * 64;
    LAS float* part = vs + 32 * 64;
    const bf16* P = (const bf16*)(F.ws + WS_P); bf16* Y = (bf16*)(F.ws + WS_Y);
    const int t = tid, e = t & 63, dg = t >> 6;
    const float gamma = 1.0f - __builtin_amdgcn_exp2f(-5.0f - (float)h), g127 = __builtin_amdgcn_exp2f(127.0f * pg8::lg2_gamma(h));
    const float gn = inp(7)[l * 256 + h * 64 + e];
    float S[8], R[8];
#pragma unroll
    for (int i = 0; i < 8; ++i) S[i] = 0.f;
    const size_t rowbase = (size_t)b * SEQ;
    for (int ch = 0; ch < SEQ / 128; ++ch) {
#pragma unroll
        for (int i = 0; i < 8; ++i) R[i] = gamma * S[i];
        for (int sub = 0; sub < 4; ++sub) {
            const size_t row0 = rowbase + ch * 128 + sub * 32;
            __syncthreads();
            for (int x = t; x < 3 * 32 * 64; x += NTHR) { const int which = x >> 11, i = (x >> 6) & 31, d = x & 63;
                qs[x] = bf2f(P[(row0 + i) * INW + (which == 0 ? PC_RQ : which == 1 ? PC_RK : PC_RV) + h * 64 + d]); }
            __syncthreads();
            for (int i = 0; i < 32; ++i) { const float ve = vs[i * 64 + e]; float pt = 0.f;
#pragma unroll
                for (int ii = 0; ii < 8; ++ii) { R[ii] += ks[i * 64 + dg * 8 + ii] * ve; pt += qs[i * 64 + dg * 8 + ii] * R[ii]; }
                part[(i * 8 + dg) * 64 + e] = pt; }
            __syncthreads();
#pragma unroll
            for (int j = 0; j < 4; ++j) { const int i = dg * 4 + j; float y = 0.f;
#pragma unroll
                for (int d8 = 0; d8 < 8; ++d8) y += part[(i * 8 + d8) * 64 + e];
                const float mean = wave_sum(y) * (1.f / 64.f), dl = y - mean, var = wave_sum(dl * dl) * (1.f / 64.f);
                const float sg = bf2f(P[(row0 + i) * INW + PC_RG + h * 64 + e]);
                Y[(row0 + i) * DM + 768 + h * 64 + e] = (bf16)f2bf(dl / sqrtf(var + NORM_EPS) * gn * sg); }
        }
#pragma unroll
        for (int i = 0; i < 8; ++i) S[i] = g127 * R[i];
    }
}
__device__ __forceinline__ void mixers_naive_phase(Frame& F, int l) {
    if (F.vcu < BATCH * 4) ret_naive_unit(F, l, F.vcu >> 2, F.vcu & 3);
    for (int i = 0;; ++i) { const int idx = i * F.G + ((i & 1) ? F.G - 1 - F.vcu : F.vcu); if (idx >= BATCH * 4 * (SEQ / 64)) break;
        const int bh = idx & 31, qb = SEQ / 64 - 1 - (idx >> 5);
        attn_naive_unit(F, bh >> 2, bh & 3, qb); }
}

#ifndef MK_ONE_LAUNCH
#define MK_ONE_LAUNCH 1
#endif
constexpr int N_PHASES = 24;
struct Args { const float* in[20]; float* out; unsigned char* ws; int ph_lo, ph_hi; };
__global__ void __launch_bounds__(NTHR, 2) hymba_fwd(Args args) {
    extern __shared__ __attribute__((aligned(16))) unsigned char lds[];
    Frame F;
    F.lds = (LAS unsigned char*)lds;
    F.MISC = (volatile LAS unsigned*)(F.lds + MISC_OFF);
    F.G = gridDim.x; { const int bx = blockIdx.x; F.vcu = (F.G % 8 == 0) ? (bx % 8) * (F.G / 8) + bx / 8 : bx; }
    F.ws = args.ws; F.out = args.out; F.ctl = (gu32*)(args.ws + WS_CTL);
    for (int u = threadIdx.x; u < (LDS_BYTES - LDSCTL_OFF) / 4; u += NTHR) ((LAS unsigned*)(F.lds + LDSCTL_OFF))[u] = 0u;
    __syncthreads();
#if MK_ONE_LAUNCH
    XcdBarrier bar = xcd_barrier_post((unsigned*)(F.ctl + CW_BAR), F.MISC + 8);
#define GRID_BAR() xcd_barrier(bar)
#else
#define GRID_BAR() do {} while (0)
#endif
    const int lo = args.ph_lo, hi = args.ph_hi;
#ifndef PHASE_OK
#define PHASE_OK(k) true
#endif
#define IN(k) (PHASE_OK(k) && lo <= (k) && (k) < hi)
#define SEAM(k) do { if (IN((k) + 1)) GRID_BAR(); } while (0)
    unsigned char* ws = args.ws;
    bf16* XB = (bf16*)(ws + WS_XB); bf16* Y = (bf16*)(ws + WS_Y); bf16* P = (bf16*)(ws + WS_P); bf16* X1 = (bf16*)(ws + WS_O);

    if (IN(0)) { p0_prologue(F); SEAM(0); }

    for (int l = 0; l < DEPTH; ++l) {
        const int pb = 1 + 8 * l;
        if (IN(pb + 0)) {
            pg8::Gemm g{XB, (const bf16*)(ws + WS_WIN) + (size_t)l * INW * DM, MROWS, INW, DM, 0};
            pg8::GOrder S; S.init(MROWS / 256, INW, F.G, (int)blockIdx.x, 0, 0, nullptr, 0);
            pg8::EpiInProj E{P};
            pg8::gemm_phase<pg8::EpiInProj, pg8::GOrder, true, true>(F.lds + RING_OFF, g, S, E);
            SEAM(pb + 0);
        }
        if (IN(pb + 1)) { mixers_naive_phase(F, l); SEAM(pb + 1); }
        if (IN(pb + 2)) { combine_phase(F, l); SEAM(pb + 2); }
        if (IN(pb + 3)) {
            pg8::Gemm g{Y, (const bf16*)(ws + WS_WOUT) + (size_t)l * DM * DM, MROWS, DM, DM, 0};
            pg8::GOrder S; S.init(MROWS / 256, DM, F.G, (int)blockIdx.x, 0, 0, nullptr, 0);
            pg8::EpiResid E{XB, F.out, ALPHA};
            pg8::gemm_phase<pg8::EpiResid, pg8::GOrder, true, true>(F.lds + RING_OFF, g, S, E);
            SEAM(pb + 3);
        }
        if (l == 0) {
            if (IN(5)) { ln1_phase<false>(F, l); SEAM(5); }
            if (IN(6)) {
                pg8::Gemm g{X1, (const bf16*)(ws + WS_WGU), MROWS, 2 * FFD, DM, 0};
                pg8::GOrder S; S.init(MROWS / 256, 2 * FFD, F.G, (int)blockIdx.x, 0, 0, nullptr, 0);
                pg8::EpiSwiGLU E{P, FFD};
                pg8::gemm_phase<pg8::EpiSwiGLU, pg8::GOrder, true, true>(F.lds + RING_OFF, g, S, E);
                SEAM(6);
            }
            if (IN(7)) {
                pg8::Gemm g{P, (const bf16*)(ws + WS_WD), MROWS, DM, FFD, 0};
                pg8::GOrder S; S.init(MROWS / 256, DM, F.G, (int)blockIdx.x, 0, 0, nullptr, 0);
                pg8::EpiResid E{X1, F.out, ALPHA};
                pg8::gemm_phase<pg8::EpiResid, pg8::GOrder, true, true>(F.lds + RING_OFF, g, S, E);
                SEAM(7);
            }
            if (IN(8)) { ln2_phase(F, l); SEAM(8); }
        } else {
            if (IN(13)) { ln1_phase<true>(F, l); SEAM(13); }
            if (IN(14)) { route_phase(F); SEAM(14); }
            const int* mi = (const int*)(ws + WS_MI);
            bf16* HQ = (bf16*)(ws + WS_HQ); bf16* XG = (bf16*)(ws + WS_XG);
            for (int q = 0; q < NQ; ++q) {
                if (IN(15 + 2 * q) || IN(16 + 2 * q)) {
                    const int ntiles = (int)__builtin_amdgcn_readfirstlane((int)__hip_atomic_load(mi, __ATOMIC_RELAXED, __HIP_MEMORY_SCOPE_AGENT));
                    const int t0 = (int)(((long)ntiles * q) / NQ), t1 = (int)(((long)ntiles * (q + 1)) / NQ);
                    if (IN(15 + 2 * q)) {
                        pg8::Gemm g{XG, (const bf16*)(ws + WS_MGU), (t1 - t0) * 256, 2 * EDIM, DM, (size_t)2 * EDIM * DM * 2};
                        pg8::GOrder S; S.init(t1 - t0, 2 * EDIM, F.G, (int)blockIdx.x, t0, 0, mi + 16, t0);
                        pg8::EpiSwiGLU E{HQ, EDIM};
                        pg8::gemm_phase<pg8::EpiSwiGLU, pg8::GOrder, true, true>(F.lds + RING_OFF, g, S, E);
                        SEAM(15 + 2 * q);
                    }
                    if (IN(16 + 2 * q)) {
                        pg8::Gemm g{HQ, (const bf16*)(ws + WS_MD), (t1 - t0) * 256, DM, EDIM, (size_t)EDIM * DM * 2};
                        pg8::GOrder S; S.init(t1 - t0, DM, F.G, (int)blockIdx.x, 0, t0, mi + 16, t0);
                        pg8::EpiPlain E{XG, DM};
                        pg8::gemm_phase<pg8::EpiPlain, pg8::GOrder, true, true>(F.lds + RING_OFF, g, S, E);
                        SEAM(16 + 2 * q);
                    }
                }
            }
            if (IN(23)) { moe_out_phase(F, l); }
        }
    }
#undef IN
#undef SEAM
}

extern "C" void kernel_launch(void* const* d_in, const int* in_sizes, int n_in, void* d_out, int out_size, void* d_ws, size_t ws_size, hipStream_t stream) {
    static int grid = 0;
    if (grid == 0) {
        if (n_in != 20 || in_sizes[0] != MROWS * DM || out_size != MROWS * DM || ws_size < WS_END) { fprintf(stderr, "kernel_launch: unexpected shapes (n_in %d, ws %zu); nothing launched\n", n_in, ws_size); grid = -1; return; }
        int dev = 0, cus = 0, per_cu = 0;
        if (hipGetDevice(&dev) != hipSuccess || hipDeviceGetAttribute(&cus, hipDeviceAttributeMultiprocessorCount, dev) != hipSuccess) { grid = -1; return; }
        if (hipFuncSetAttribute((const void*)hymba_fwd, hipFuncAttributeMaxDynamicSharedMemorySize, LDS_BYTES) != hipSuccess) { grid = -1; return; }
        if (hipOccupancyMaxActiveBlocksPerMultiprocessor(&per_cu, (const void*)hymba_fwd, NTHR, LDS_BYTES) != hipSuccess || per_cu < 1) { fprintf(stderr, "kernel_launch: occupancy query reports %d\n", per_cu); }
        (void)hipGetLastError();
        grid = cus;
    }
    if (grid < 0) return;
    if (hipMemsetAsync((char*)d_ws + WS_CTL, 0, CTL_ZERO_BYTES, stream) != hipSuccess) return;
    Args a{};
    for (int i = 0; i < 20; ++i) a.in[i] = (const float*)d_in[i];
    a.out = (float*)d_out; a.ws = (unsigned char*)d_ws;
#if MK_ONE_LAUNCH
    a.ph_lo = 0; a.ph_hi = N_PHASES;
    hipLaunchKernelGGL(hymba_fwd, dim3(grid), dim3(NTHR), LDS_BYTES, stream, a);
#else
    for (int p = 0; p < N_PHASES; ++p) { a.ph_lo = p; a.ph_hi = p + 1; hipLaunchKernelGGL(hymba_fwd, dim3(grid), dim3(NTHR), LDS_BYTES, stream, a); }
#endif
}
```

```cpp
#include <hip/hip_runtime.h>
#include <cstdio>
#include <cstdint>
#include <cmath>
#include <hip/hip_bf16.h>
#define MK_ONE_LAUNCH 1
namespace pg8 {
#define PG8_LAS __attribute__((address_space(3)))
typedef unsigned short bf16_t;
typedef short bf16x8 __attribute__((ext_vector_type(8)));
typedef float f32x4 __attribute__((ext_vector_type(4)));
typedef unsigned u32x4 __attribute__((ext_vector_type(4)));
constexpr int BM = 256, BK = 64, HALF = 128, HTB = HALF * BK * 2  , STAGE_BYTES = 8 * HTB, NXCD = 8, WGM = 8;

__host__ __device__ __forceinline__ int lds_byte(int r, int c) { const int st = (r >> 4) * 2 + (c >> 5), rr = r & 15, cc = c & 31, ob = rr * 64 + cc * 2; return st * 1024 + (ob ^ (((ob >> 9) & 1) << 5)); }
__host__ __device__ __forceinline__ void stage_rc(int b, int& R, int& C) { const int st = b / 1024, sb = b % 1024, swz = sb ^ (((sb >> 9) & 1) << 5); R = (st >> 1) * 16 + swz / 64; C = (st & 1) * 32 + (swz % 64) / 2; }
__host__ __device__ __forceinline__ int perm32(int rho) { const int n = rho >> 4, i = rho & 15; return 8 * (i >> 2) + 4 * n + (i & 3); }

struct Unit { int pm, pn, am, e; };
struct Gemm { const bf16_t* A; const bf16_t* Bt; int M, N, K; size_t bstride; };

struct StaticOrder {
    int nM, nN, nwg, G, c;
    __host__ __device__ void init(int M, int N, int G_, int c_) { nM = M / BM; nN = N / BM; nwg = nM * nN; G = G_; c = c_; }
    __host__ __device__ bool next(int i, Unit& u) const { return unit_of((long)i * G + c, u); }
    __host__ __device__ bool unit_of(long L, Unit& u) const {
        if (L >= nwg) return false;
        int wgid = (int)L; { const int q = nwg / NXCD, r = nwg % NXCD, xcd = wgid % NXCD, off = wgid / NXCD; wgid = (xcd < r ? xcd * (q + 1) : r * (q + 1) + (xcd - r) * q) + off; }
        const int nig = WGM * nN, gid = wgid / nig, fm = gid * WGM, gsz = (nM - fm) < WGM ? (nM - fm) : WGM;
        u.pm = fm + ((wgid % nig) % gsz); u.pn = (wgid % nig) / gsz; u.am = u.pm; u.e = 0; return true;
    }
    __device__ __forceinline__ void a_ready(const Unit&) const {}
    __device__ __forceinline__ void done(const Unit&) const {}
};

__device__ __forceinline__ unsigned cvt_pk_bf16(float lo, float hi) { unsigned r; asm volatile("v_cvt_pk_bf16_f32 %0, %1, %2" : "=v"(r) : "v"(lo), "v"(hi)); return r; }
typedef float f32x2 __attribute__((ext_vector_type(2)));
typedef unsigned u32x2 __attribute__((ext_vector_type(2)));
__device__ __forceinline__ float bf_lo(unsigned w) { return __uint_as_float(w << 16); }
__device__ __forceinline__ float bf_hi(unsigned w) { return __uint_as_float(w & 0xffff0000u); }
__device__ __forceinline__ float silu_f(float x) { return x * __builtin_amdgcn_rcpf(1.0f + __builtin_amdgcn_exp2f(-1.4426950408889634f * x)); }
__device__ __forceinline__ float lg2_gamma(int h) { return h == 0 ? -0.04580368961312479f : h == 1 ? -0.02272007650008353f : h == 2 ? -0.011315313227834146f : -0.005646563141142063f; }
typedef float f32x2e __attribute__((ext_vector_type(2)));
__device__ __forceinline__ f32x2e swiglu_pk(f32x2e g, f32x2e u) {
    const f32x2e t = g * (-1.4426950408889634f); f32x2e ex; ex.x = __builtin_amdgcn_exp2f(t.x); ex.y = __builtin_amdgcn_exp2f(t.y);
    const f32x2e d = ex + 1.0f; f32x2e s; s.x = __builtin_amdgcn_rcpf(d.x); s.y = __builtin_amdgcn_rcpf(d.y);
    return (g * u) * s; }
constexpr float QSCALE = 0.18033688011112042f;

struct GOrder {
    StaticOrder so; int a_off, o_off; const PG8_LAS int* tile_e; int xd, sd;
    __device__ __forceinline__ void init(int ntiles, int N, int G, int c, int a_off_, int o_off_, const PG8_LAS int* te) { so.init(ntiles * BM, N, G, c); a_off = a_off_; o_off = o_off_; tile_e = te; xd = 0; sd = 8; }
    __device__ __forceinline__ void donate(int xd_) { xd = xd_; sd = (xd_ + 7) & ~7; }
    __device__ __forceinline__ bool next(int i, Unit& u) const {
        long L = (long)i * so.G + so.c;
        if (xd > 0) { const int R = so.nwg / so.G;
            if (so.c < xd) { if (i >= R - 3) return false; }
            else if (i >= R) { const int k = so.c / sd - 1, cd = so.c - (k + 1) * sd; if (i > R || k < 0 || k > 2 || cd >= xd) return false; L = (long)(R - 3 + k) * so.G + cd; } }
        if (!so.unit_of(L, u)) return false;
        const int loc = u.pm; u.am = loc + a_off; u.pm = loc + o_off;
        u.e = tile_e ? (int)__builtin_amdgcn_readfirstlane(tile_e[loc]) : 0; return true;
    }
    __device__ __forceinline__ void a_ready(const Unit&) const {}
    __device__ __forceinline__ void done(const Unit&) const {}
};

struct EpiInProj {
    static constexpr bool PERM = true, AFTER_DRAIN = false;
    bf16_t* O;
    __device__ __forceinline__ void operator()(const f32x4 (&acc)[2][2][4][2], const Unit& u, int wr, int wc, int fr, int fq) const {
        constexpr int LDC = 2816;
        const int row0 = u.pm * BM + wr * 64 + fr, col0 = u.pn * BM + wc * 32 + 8 * fq, pn = u.pn;
        const int kind = (pn < 2) ? 1 : (pn == 7) ? 2 : (pn == 8) ? 3 : (pn == 10) ? 4 : 0;
        if (kind == 2 || kind == 3) {
            const int i0 = (wc & 1) * 16 + 4 * fq;
            float inv4[4];
#pragma unroll
            for (int jj = 0; jj < 4; ++jj) inv4[jj] = __builtin_amdgcn_exp2f(-(float)(i0 + jj) * 0.42863588321127255f);
            const float lg0 = lg2_gamma(wc >> 1), lg1 = lg2_gamma(2 + (wc >> 1));
#pragma unroll
            for (int ai = 0; ai < 2; ++ai)
#pragma unroll
                for (int m = 0; m < 4; ++m) {
                    const int row = row0 + ai * HALF + m * 16, pos = row & 8191; const float fi = (float)(pos & 127);
                    bf16_t* rowp = O + (size_t)row * LDC + col0;
                    float cs[4], sn[4];
#pragma unroll
                    for (int jj = 0; jj < 4; ++jj) { const float ang = (float)pos * inv4[jj]; float rv = ang * 0.15915494309189535f; rv = rv - __builtin_floorf(rv); cs[jj] = __builtin_amdgcn_cosf(rv); sn[jj] = __builtin_amdgcn_sinf(rv); }
#pragma unroll
                    for (int bj = 0; bj < 2; ++bj) {
                        const float lg = bj ? lg1 : lg0;
                        const float f = (kind == 2) ? __builtin_amdgcn_exp2f(fi * lg) : 0.125f * __builtin_amdgcn_exp2f(-fi * lg);
                        const f32x4 v0 = acc[ai][bj][m][0], v1 = acc[ai][bj][m][1];
                        const float a0 = (v0[0] * cs[0] - v0[1] * sn[0]) * f, b0 = (v0[0] * sn[0] + v0[1] * cs[0]) * f;
                        const float a1 = (v0[2] * cs[1] - v0[3] * sn[1]) * f, b1 = (v0[2] * sn[1] + v0[3] * cs[1]) * f;
                        const float a2 = (v1[0] * cs[2] - v1[1] * sn[2]) * f, b2 = (v1[0] * sn[2] + v1[1] * cs[2]) * f;
                        const float a3 = (v1[2] * cs[3] - v1[3] * sn[3]) * f, b3 = (v1[2] * sn[3] + v1[3] * cs[3]) * f;
                        u32x4 w; w.x = cvt_pk_bf16(a0, b0); w.y = cvt_pk_bf16(a1, b1); w.z = cvt_pk_bf16(a2, b2); w.w = cvt_pk_bf16(a3, b3);
                        *(u32x4*)(rowp + bj * HALF) = w; }
                }
        } else {
            const float sc = (kind == 1) ? QSCALE : 1.0f;
#pragma unroll
            for (int ai = 0; ai < 2; ++ai)
#pragma unroll
                for (int m = 0; m < 4; ++m) { bf16_t* rowp = O + (size_t)(row0 + ai * HALF + m * 16) * LDC + col0;
#pragma unroll
                    for (int bj = 0; bj < 2; ++bj) { f32x4 v0 = acc[ai][bj][m][0] * sc, v1 = acc[ai][bj][m][1] * sc;
                        if (kind == 4) { v0 = (f32x4){silu_f(v0[0]), silu_f(v0[1]), silu_f(v0[2]), silu_f(v0[3])}; v1 = (f32x4){silu_f(v1[0]), silu_f(v1[1]), silu_f(v1[2]), silu_f(v1[3])}; }
                        u32x4 w; w.x = cvt_pk_bf16(v0[0], v0[1]); w.y = cvt_pk_bf16(v0[2], v0[3]); w.z = cvt_pk_bf16(v1[0], v1[1]); w.w = cvt_pk_bf16(v1[2], v1[3]);
                        *(u32x4*)(rowp + bj * HALF) = w; } }
        }
    }
};
struct EpiResid {
    static constexpr bool PERM = true, AFTER_DRAIN = false;
    const bf16_t* X; bf16_t* T; float alpha;
    __device__ __forceinline__ void operator()(const f32x4 (&acc)[2][2][4][2], const Unit& u, int wr, int wc, int fr, int fq) const {
        const int row0 = u.pm * BM + wr * 64 + fr, col0 = u.pn * BM + wc * 32 + 8 * fq;
#pragma unroll
        for (int ai = 0; ai < 2; ++ai)
#pragma unroll
            for (int m = 0; m < 4; ++m) { const size_t off = (size_t)(row0 + ai * HALF + m * 16) * 1024 + col0;
#pragma unroll
                for (int bj = 0; bj < 2; ++bj) { const u32x4 xr = *(const u32x4*)(X + off + bj * HALF); const f32x4 v0 = acc[ai][bj][m][0], v1 = acc[ai][bj][m][1];
                    u32x4 w; w.x = cvt_pk_bf16(alpha * bf_lo(xr.x) + v0[0], alpha * bf_hi(xr.x) + v0[1]); w.y = cvt_pk_bf16(alpha * bf_lo(xr.y) + v0[2], alpha * bf_hi(xr.y) + v0[3]);
                    w.z = cvt_pk_bf16(alpha * bf_lo(xr.z) + v1[0], alpha * bf_hi(xr.z) + v1[1]); w.w = cvt_pk_bf16(alpha * bf_lo(xr.w) + v1[2], alpha * bf_hi(xr.w) + v1[3]);
                    *(u32x4*)(T + off + bj * HALF) = w; } }
    }
};
struct EpiSwiGLU {
    static constexpr bool PERM = true, AFTER_DRAIN = false;
    bf16_t* H; int ldc;
    __device__ __forceinline__ void operator()(const f32x4 (&acc)[2][2][4][2], const Unit& u, int wr, int wc, int fr, int fq) const {
        const int row0 = u.pm * BM + wr * 64 + fr, col0 = u.pn * HALF + wc * 32 + 8 * fq;
#pragma unroll
        for (int ai = 0; ai < 2; ++ai)
#pragma unroll
            for (int m = 0; m < 4; ++m) { bf16_t* p = H + (size_t)(row0 + ai * HALF + m * 16) * ldc + col0;
                const f32x4 g0 = acc[ai][0][m][0], g1 = acc[ai][0][m][1], u0 = acc[ai][1][m][0], u1 = acc[ai][1][m][1];
                const f32x2e a = swiglu_pk((f32x2e){g0[0], g0[1]}, (f32x2e){u0[0], u0[1]}), b = swiglu_pk((f32x2e){g0[2], g0[3]}, (f32x2e){u0[2], u0[3]});
                const f32x2e c = swiglu_pk((f32x2e){g1[0], g1[1]}, (f32x2e){u1[0], u1[1]}), d = swiglu_pk((f32x2e){g1[2], g1[3]}, (f32x2e){u1[2], u1[3]});
                u32x4 w; w.x = cvt_pk_bf16(a.x, a.y); w.y = cvt_pk_bf16(b.x, b.y); w.z = cvt_pk_bf16(c.x, c.y); w.w = cvt_pk_bf16(d.x, d.y);
                *(u32x4*)p = w; }
    }
};
struct EpiPlain {
    static constexpr bool PERM = true, AFTER_DRAIN = false;
    bf16_t* O; int ldc;
    __device__ __forceinline__ void operator()(const f32x4 (&acc)[2][2][4][2], const Unit& u, int wr, int wc, int fr, int fq) const {
        const int row0 = u.pm * BM + wr * 64 + fr, col0 = u.pn * BM + wc * 32 + 8 * fq;
#pragma unroll
        for (int ai = 0; ai < 2; ++ai)
#pragma unroll
            for (int m = 0; m < 4; ++m) { bf16_t* rowp = O + (size_t)(row0 + ai * HALF + m * 16) * ldc + col0;
#pragma unroll
                for (int bj = 0; bj < 2; ++bj) { const f32x4 v0 = acc[ai][bj][m][0], v1 = acc[ai][bj][m][1];
                    u32x4 w; w.x = cvt_pk_bf16(v0[0], v0[1]); w.y = cvt_pk_bf16(v0[2], v0[3]); w.z = cvt_pk_bf16(v1[0], v1[1]); w.w = cvt_pk_bf16(v1[2], v1[3]);
                    *(u32x4*)(rowp + bj * HALF) = w; } }
    }
};

constexpr float F8_SX = 8.0f, F8_SU = 256.0f, F8_SH = 8.0f, F8_SD = 1024.0f, F8_SY = 64.0f;
__device__ __forceinline__ unsigned pk4_fp8(float a, float b, float c, float d) {
    int w = 0; w = __builtin_amdgcn_cvt_pk_fp8_f32(a, b, w, false); w = __builtin_amdgcn_cvt_pk_fp8_f32(c, d, w, true); return (unsigned)w; }
__device__ __forceinline__ float clamp_f8(float v) { return __builtin_fminf(__builtin_fmaxf(v, -448.0f), 448.0f); }
struct EpiSwiGLU8 {
    static constexpr bool PERM = true, AFTER_DRAIN = false;
    unsigned char* H; int ldc;
    static __device__ __forceinline__ f32x2e h8(f32x2e g, f32x2e u) {
        constexpr float IS = 1.0f / (F8_SX * F8_SU);
        const f32x2e t = g * (-1.4426950408889634f * IS); f32x2e ex; ex.x = __builtin_amdgcn_exp2f(t.x); ex.y = __builtin_amdgcn_exp2f(t.y);
        const f32x2e d = ex + 1.0f; f32x2e s; s.x = __builtin_amdgcn_rcpf(d.x); s.y = __builtin_amdgcn_rcpf(d.y);
        f32x2e r = (g * u) * (s * (IS * IS * F8_SH)); r.x = __builtin_amdgcn_fmed3f(r.x, -448.0f, 448.0f); r.y = __builtin_amdgcn_fmed3f(r.y, -448.0f, 448.0f); return r; }
    __device__ __forceinline__ void operator()(const f32x4 (&acc)[2][2][4][2], const Unit& u, int wr, int wc, int fr, int fq) const {
        const int row0 = u.pm * BM + wr * 64 + fr, col0 = u.pn * HALF + wc * 32 + 8 * fq;
#pragma unroll
        for (int ai = 0; ai < 2; ++ai)
#pragma unroll
            for (int m = 0; m < 4; ++m) { unsigned char* p = H + (size_t)(row0 + ai * HALF + m * 16) * ldc + col0;
                const f32x4 g0 = acc[ai][0][m][0], g1 = acc[ai][0][m][1], u0 = acc[ai][1][m][0], u1 = acc[ai][1][m][1];
                const f32x2e a = h8((f32x2e){g0[0], g0[1]}, (f32x2e){u0[0], u0[1]}), b = h8((f32x2e){g0[2], g0[3]}, (f32x2e){u0[2], u0[3]});
                const f32x2e c = h8((f32x2e){g1[0], g1[1]}, (f32x2e){u1[0], u1[1]}), d = h8((f32x2e){g1[2], g1[3]}, (f32x2e){u1[2], u1[3]});
                u32x2 w; w.x = pk4_fp8(a.x, a.y, b.x, b.y); w.y = pk4_fp8(c.x, c.y, d.x, d.y);
                *(u32x2*)p = w; }
    }
};
struct EpiPlain8 {
    static constexpr bool PERM = true, AFTER_DRAIN = false;
    unsigned char* O; int ldc; float scale;
    __device__ __forceinline__ void operator()(const f32x4 (&acc)[2][2][4][2], const Unit& u, int wr, int wc, int fr, int fq) const {
        const int row0 = u.pm * BM + wr * 64 + fr, col0 = u.pn * BM + wc * 32 + 8 * fq;
#pragma unroll
        for (int ai = 0; ai < 2; ++ai)
#pragma unroll
            for (int m = 0; m < 4; ++m) { unsigned char* rowp = O + (size_t)(row0 + ai * HALF + m * 16) * ldc + col0;
#pragma unroll
                for (int bj = 0; bj < 2; ++bj) { f32x4 v0 = acc[ai][bj][m][0] * scale, v1 = acc[ai][bj][m][1] * scale;
#pragma unroll
                    for (int q = 0; q < 4; ++q) { v0[q] = __builtin_amdgcn_fmed3f(v0[q], -448.0f, 448.0f); v1[q] = __builtin_amdgcn_fmed3f(v1[q], -448.0f, 448.0f); }
                    u32x2 w; w.x = pk4_fp8(v0[0], v0[1], v0[2], v0[3]); w.y = pk4_fp8(v1[0], v1[1], v1[2], v1[3]);
                    *(u32x2*)(rowp + bj * HALF) = w; } }
    }
};
struct EpiPlainS {
    static constexpr bool PERM = true, AFTER_DRAIN = false;
    bf16_t* O; int ldc; float scale;
    __device__ __forceinline__ void operator()(const f32x4 (&acc)[2][2][4][2], const Unit& u, int wr, int wc, int fr, int fq) const {
        const int row0 = u.pm * BM + wr * 64 + fr, col0 = u.pn * BM + wc * 32 + 8 * fq;
#pragma unroll
        for (int ai = 0; ai < 2; ++ai)
#pragma unroll
            for (int m = 0; m < 4; ++m) { bf16_t* rowp = O + (size_t)(row0 + ai * HALF + m * 16) * ldc + col0;
#pragma unroll
                for (int bj = 0; bj < 2; ++bj) { const f32x4 v0 = acc[ai][bj][m][0] * scale, v1 = acc[ai][bj][m][1] * scale;
                    u32x4 w; w.x = cvt_pk_bf16(v0[0], v0[1]); w.y = cvt_pk_bf16(v0[2], v0[3]); w.z = cvt_pk_bf16(v1[0], v1[1]); w.w = cvt_pk_bf16(v1[2], v1[3]);
                    *(u32x4*)(rowp + bj * HALF) = w; } }
    }
};
template <class Epi, class Sched, bool ALIGN_EPI = false, bool SP2 = false, bool F8 = false>
__device__ __forceinline__ void gemm_phase(PG8_LAS unsigned char* lds, const Gemm g, const Sched& S, const Epi& E) {
    int tid_ = threadIdx.x; asm volatile("" : "+v"(tid_));
    const int tid = tid_, wid = __builtin_amdgcn_readfirstlane(tid >> 6), lane = tid & 63, wr = wid >> 2, wc = wid & 3, fr = lane & 15, fq = lane >> 4;
    const int K = F8 ? g.K / 2 : g.K  , nt = K / BK;
    unsigned voffA[2], voffB[2];
#pragma unroll
    for (int i = 0; i < 2; ++i) { int R, C; stage_rc(tid * 16 + i * 8192, R, C); const int Rb = Epi::PERM ? ((R & ~31) + perm32(R & 31)) : R;
        voffA[i] = (unsigned)(R * K + C) * 2u; voffB[i] = (unsigned)(Rb * K + C) * 2u; }
    const size_t kstep = (size_t)(BK * 2);
    const size_t hstep = (size_t)HALF * K * 2;
    const size_t tstep = 2 * hstep;
    const unsigned ldsw = (unsigned)wid * 1024u;
    const int aoff = lds_byte(wr * 64 + fr, fq * 8), boff = lds_byte(wc * 32 + fr, fq * 8);
#define PG8_SA(b, h) (((b) * 2 + (h)) * HTB)
#define PG8_SB(b, h) ((4 + (b) * 2 + (h)) * HTB)
#define PG8_STAGE(bufoff, gbase, voff) do { _Pragma("unroll") for (int _i = 0; _i < 2; ++_i) \
        __builtin_amdgcn_global_load_lds((const unsigned*)((const char*)(gbase) + (voff)[_i]), (PG8_LAS unsigned*)(lds + (bufoff) + ldsw + _i * 8192), 16, 0, 0); } while (0)
#define PG8_LDA(dst, b, h) do { _Pragma("unroll") for (int m = 0; m < 4; ++m) { if constexpr (F8) { const v4i_ lo_ = *(const PG8_LAS v4i_*)(lds + PG8_SA(b, h) + aoff + m * 2048), hi_ = *(const PG8_LAS v4i_*)(lds + PG8_SA(b, h) + aoff + m * 2048 + 1024); dst##8[m] = __builtin_shufflevector(lo_, hi_, 0, 1, 2, 3, 4, 5, 6, 7); } \
        else { _Pragma("unroll") for (int k = 0; k < 2; ++k) dst[m][k] = *(const PG8_LAS bf16x8*)(lds + PG8_SA(b, h) + aoff + m * 2048 + k * 1024); } } } while (0)
#define PG8_LDB(dst, b, h) do { _Pragma("unroll") for (int n = 0; n < 2; ++n) { if constexpr (F8) { const v4i_ lo_ = *(const PG8_LAS v4i_*)(lds + PG8_SB(b, h) + boff + n * 2048), hi_ = *(const PG8_LAS v4i_*)(lds + PG8_SB(b, h) + boff + n * 2048 + 1024); dst##8[n] = __builtin_shufflevector(lo_, hi_, 0, 1, 2, 3, 4, 5, 6, 7); } \
        else { _Pragma("unroll") for (int k = 0; k < 2; ++k) dst[n][k] = *(const PG8_LAS bf16x8*)(lds + PG8_SB(b, h) + boff + n * 2048 + k * 1024); } } } while (0)
#define PG8_MMA(ai, bj, At, Bt) do { __builtin_amdgcn_s_setprio(1); _Pragma("unroll") for (int m = 0; m < 4; ++m) _Pragma("unroll") for (int n = 0; n < 2; ++n) { \
        if constexpr (F8) asm volatile("v_mfma_scale_f32_16x16x128_f8f6f4 %0, %1, %2, %0, %3, %3 op_sel_hi:[0,0,0]" : "+v"(acc[ai][bj][m][n]) : "v"(Bt##8[n]), "v"(At##8[m]), "v"(f8scale_));   \
        else { _Pragma("unroll") for (int k = 0; k < 2; ++k) acc[ai][bj][m][n] = __builtin_amdgcn_mfma_f32_16x16x32_bf16(Bt[n][k], At[m][k], acc[ai][bj][m][n], 0, 0, 0); } } \
        __builtin_amdgcn_s_setprio(0); } while (0)
#define PG8_WAIT_V(n) asm volatile("s_waitcnt vmcnt(" #n ")" ::: "memory")
#define PG8_WAIT_L(n) asm volatile("s_waitcnt lgkmcnt(" #n ")" ::: "memory")
#define PG8_BAR __builtin_amdgcn_s_barrier()
#define PG8_SCHED __builtin_amdgcn_sched_barrier(0)
    Unit cur, nxt; int ui = 0;
    if (!S.next(0, cur)) return;
    f32x4 acc[2][2][4][2];
#pragma unroll
    for (int a = 0; a < 2; ++a)
#pragma unroll
        for (int b = 0; b < 2; ++b)
#pragma unroll
            for (int m = 0; m < 4; ++m)
#pragma unroll
                for (int n = 0; n < 2; ++n) acc[a][b][m][n] = (f32x4){0.f, 0.f, 0.f, 0.f};
    typedef int v4i_ __attribute__((ext_vector_type(4))); typedef int v8i_ __attribute__((ext_vector_type(8)));
    int f8scale_ = 0x7F7F7F7F; asm volatile("" : "+v"(f8scale_));
    bf16x8 At[4][2], B0[2][2], B1[2][2]; v8i_ At8[4], B08[2], B18[2];
    const char* cA = (const char*)g.A + (size_t)cur.am * tstep; const char* cB = (const char*)g.Bt + (size_t)cur.e * g.bstride + (size_t)cur.pn * tstep;
    S.a_ready(cur);
    if constexpr (SP2) {
        PG8_STAGE(PG8_SB(0, 0), cB, voffB); PG8_STAGE(PG8_SB(0, 1), cB + hstep, voffB); PG8_STAGE(PG8_SA(0, 0), cA, voffA); PG8_STAGE(PG8_SA(0, 1), cA + hstep, voffA);
        if (wr == 1) PG8_BAR;
        PG8_WAIT_V(2); PG8_BAR;
        PG8_STAGE(PG8_SB(1, 0), cB + kstep, voffB); PG8_STAGE(PG8_SA(1, 0), cA + kstep, voffA); PG8_STAGE(PG8_SB(1, 1), cB + hstep + kstep, voffB);
        PG8_WAIT_V(6); PG8_BAR;
    } else {
        PG8_STAGE(PG8_SB(0, 0), cB, voffB); PG8_STAGE(PG8_SA(0, 0), cA, voffA); PG8_STAGE(PG8_SB(0, 1), cB + hstep, voffB); PG8_STAGE(PG8_SA(0, 1), cA + hstep, voffA);
        if (wr == 1) PG8_BAR;
        PG8_WAIT_V(4); PG8_BAR;
        PG8_STAGE(PG8_SB(1, 0), cB + kstep, voffB); PG8_STAGE(PG8_SA(1, 0), cA + kstep, voffA); PG8_STAGE(PG8_SB(1, 1), cB + hstep + kstep, voffB);
        PG8_WAIT_V(6); PG8_BAR;
    }
    for (;;) {
        const bool has_next = S.next(ui + 1, nxt);
        const char* nA = has_next ? (const char*)g.A + (size_t)nxt.am * tstep : cA; const char* nB = has_next ? (const char*)g.Bt + (size_t)nxt.e * g.bstride + (size_t)nxt.pn * tstep : cB;
        for (int t = 0; t < nt; t += 2) {
            const bool last = (t == nt - 2);
            const char* a1 = cA + (size_t)(t + 1) * kstep;
            const char* a2 = last ? nA : cA + (size_t)(t + 2) * kstep; const char* b2 = last ? nB : cB + (size_t)(t + 2) * kstep;
            const char* a3 = a2 + kstep; const char* b3 = b2 + kstep;
            if (last && has_next) S.a_ready(nxt);
            if constexpr (SP2) {
            PG8_LDB(B0, 0, 0); PG8_LDB(B1, 0, 1); PG8_SCHED; PG8_LDA(At, 0, 0); PG8_STAGE(PG8_SA(1, 1), a1 + hstep, voffA);
            PG8_WAIT_V(8); PG8_WAIT_L(0); PG8_BAR; PG8_MMA(0, 0, At, B0); PG8_MMA(0, 1, At, B1); PG8_BAR; PG8_SCHED;
            PG8_LDA(At, 0, 1); PG8_STAGE(PG8_SB(0, 0), b2, voffB); PG8_STAGE(PG8_SB(0, 1), b2 + hstep, voffB); PG8_STAGE(PG8_SA(0, 0), a2, voffA);
            PG8_WAIT_V(8); PG8_WAIT_L(0); PG8_BAR; PG8_MMA(1, 0, At, B0); PG8_MMA(1, 1, At, B1); PG8_BAR; PG8_SCHED;
            PG8_LDB(B0, 1, 0); PG8_LDB(B1, 1, 1); PG8_SCHED; PG8_LDA(At, 1, 0); PG8_STAGE(PG8_SA(0, 1), a2 + hstep, voffA);
            PG8_WAIT_V(8); PG8_WAIT_L(0); PG8_BAR; PG8_MMA(0, 0, At, B0); PG8_MMA(0, 1, At, B1); PG8_BAR; PG8_SCHED;
            PG8_LDA(At, 1, 1); PG8_STAGE(PG8_SB(1, 0), b3, voffB); PG8_STAGE(PG8_SB(1, 1), b3 + hstep, voffB); PG8_STAGE(PG8_SA(1, 0), a3, voffA);
            PG8_WAIT_V(8); PG8_WAIT_L(0); PG8_BAR; PG8_MMA(1, 0, At, B0); PG8_MMA(1, 1, At, B1); PG8_BAR; PG8_SCHED;
            } else {
            PG8_LDB(B0, 0, 0); PG8_SCHED; PG8_LDA(At, 0, 0); PG8_STAGE(PG8_SA(1, 1), a1 + hstep, voffA);
            PG8_WAIT_L(8); PG8_BAR; PG8_WAIT_L(0); PG8_MMA(0, 0, At, B0); PG8_BAR; PG8_SCHED;
            PG8_LDB(B1, 0, 1); PG8_STAGE(PG8_SB(0, 0), b2, voffB);
            PG8_BAR; PG8_WAIT_L(0); PG8_MMA(0, 1, At, B1); PG8_BAR;
            PG8_LDA(At, 0, 1); PG8_STAGE(PG8_SA(0, 0), a2, voffA);
            PG8_BAR; PG8_WAIT_L(0); PG8_MMA(1, 0, At, B0); PG8_BAR; PG8_SCHED;
            PG8_STAGE(PG8_SB(0, 1), b2 + hstep, voffB);
            PG8_WAIT_V(6); PG8_BAR; PG8_MMA(1, 1, At, B1); PG8_BAR;
            PG8_LDB(B0, 1, 0); PG8_SCHED; PG8_LDA(At, 1, 0); PG8_STAGE(PG8_SA(0, 1), a2 + hstep, voffA);
            PG8_WAIT_L(8); PG8_BAR; PG8_WAIT_L(0); PG8_MMA(0, 0, At, B0); PG8_BAR; PG8_SCHED;
            PG8_LDB(B1, 1, 1); PG8_STAGE(PG8_SB(1, 0), b3, voffB);
            PG8_BAR; PG8_WAIT_L(0); PG8_MMA(0, 1, At, B1); PG8_BAR;
            PG8_LDA(At, 1, 1); PG8_STAGE(PG8_SA(1, 0), a3, voffA);
            PG8_BAR; PG8_WAIT_L(0); PG8_MMA(1, 0, At, B0); PG8_BAR; PG8_SCHED;
            PG8_STAGE(PG8_SB(1, 1), b3 + hstep, voffB);
            PG8_WAIT_V(6); PG8_BAR; PG8_MMA(1, 1, At, B1); PG8_BAR;
            }
        }
        if constexpr (F8) asm volatile("s_nop 15\n\ts_nop 7" ::: "memory");
        if constexpr (ALIGN_EPI) { if (wr == 0) PG8_BAR; }
        if constexpr (!Epi::AFTER_DRAIN) { E(acc, cur, wr, wc, fr, fq); S.done(cur); }
        if (!has_next) break;
#pragma unroll
        for (int a = 0; a < 2; ++a)
#pragma unroll
            for (int b = 0; b < 2; ++b)
#pragma unroll
                for (int m = 0; m < 4; ++m)
#pragma unroll
                    for (int n = 0; n < 2; ++n) acc[a][b][m][n] = (f32x4){0.f, 0.f, 0.f, 0.f};
        cur = nxt; cA = nA; cB = nB; ++ui;
        if constexpr (ALIGN_EPI) { if (wr == 1) PG8_BAR; }
    }
    PG8_WAIT_V(0);
    if constexpr (!ALIGN_EPI) { if (wr == 0) PG8_BAR; }
    PG8_BAR;
    if constexpr (Epi::AFTER_DRAIN) { E.fused(acc, cur, wr, wc, fr, fq, lds, wid, lane); S.done(cur); }
#undef PG8_SA
#undef PG8_SB
#undef PG8_STAGE
#undef PG8_LDA
#undef PG8_LDB
#undef PG8_MMA
#undef PG8_WAIT_V
#undef PG8_WAIT_L
#undef PG8_BAR
#undef PG8_SCHED
}
}
namespace attn_body {
using bf16=__hip_bfloat16;
using bf16x8=__attribute__((ext_vector_type(8)))short;
using s16x4=__attribute__((ext_vector_type(4)))short;
using f32x16=__attribute__((ext_vector_type(16)))float;
using u32x4=__attribute__((ext_vector_type(4)))unsigned;
constexpr int SEQ=8192,D=64,PIN=2816,POUT=1024;
constexpr int NW=8,QBLK=32,QB=QBLK*NW,KVBLK=64,NQB=SEQ/QB;
constexpr int ATTN_UNIT_ROWS=QB;
__device__ __forceinline__ int crow(int r,int hi){return (r&3)+8*(r>>2)+4*hi;}
#define SBAR() __builtin_amdgcn_sched_barrier(0)
__device__ __forceinline__ void bmask(f32x16&p0,f32x16&p1,int rel,int qrel,int hi,const __attribute__((address_space(3))) float*lut){
  const float NEG=-INFINITY; const int base=qrel-64*rel-4*hi;
  #pragma unroll
  for(int r=0;r<16;++r){ const int d0=base-((r&3)+8*(r>>2)), d1=d0-32;
    const int i0=d0<0?0:(d0>127?127:d0), i1=d1<0?0:(d1>127?127:d1);
    const float b0=lut[i0], b1=lut[i1];
    p0[r]=d0<0?NEG:p0[r]+b0; p1[r]=d1<0?NEG:p1[r]+b1; }
}
constexpr int NSLOT=3, SLOTB=8192;
constexpr int LDS_K=0, LDS_V=NSLOT*SLOTB, LDS_WS=2*NSLOT*SLOTB, LDS_OST=LDS_WS+NW*64*4, LDS_LUT=LDS_OST+NW*4096, LDS_BYTES=LDS_LUT+512;
constexpr float C2=0.125f*1.4426950408889634f;
template<int OFF> __device__ __forceinline__ void glds16s(unsigned voff,const void*sbase,unsigned lds_dst){unsigned keep;
  asm volatile("s_mov_b32 %0, m0\n\ts_mov_b32 m0, %3\n\ts_nop 4\n\tglobal_load_lds_dwordx4 %1, %2 offset:%c4\n\ts_mov_b32 m0, %0":"=&s"(keep):"v"(voff),"s"(sbase),"s"(lds_dst),"i"(OFF):"memory");}
__device__ __forceinline__ void glds16(const void*gsrc,unsigned lds_dst){unsigned keep;
  asm volatile("s_mov_b32 %0, m0\n\ts_mov_b32 m0, %2\n\ts_nop 0\n\tglobal_load_lds_dwordx4 %1, off\n\ts_mov_b32 m0, %0":"=&s"(keep):"v"(gsrc),"s"(lds_dst):"memory");}
__device__ __forceinline__ float max3f(float a,float b,float c){float r;asm("v_max3_f32 %0, %1, %2, %3":"=v"(r):"v"(a),"v"(b),"v"(c));return r;}
__device__ __forceinline__ float max2f(float a,float b){float r;asm("v_max_f32_e32 %0, %1, %2":"=v"(r):"v"(a),"v"(b));return r;}
__device__ __forceinline__ float fadd_s(float a,float b){float r;asm("v_add_f32_e32 %0, %1, %2":"=v"(r):"v"(a),"v"(b));return r;}
__device__ __forceinline__ float fsub_s(float a,float b){float r;asm("v_sub_f32_e32 %0, %1, %2":"=v"(r):"v"(a),"v"(b));return r;}
typedef float f32x2_t __attribute__((ext_vector_type(2))); typedef __bf16 bf16x2_t __attribute__((ext_vector_type(2)));
__device__ __forceinline__ unsigned cvtpk_s(float lo,float hi){f32x2_t v={lo,hi};bf16x2_t b=__builtin_convertvector(v,bf16x2_t);return __builtin_bit_cast(unsigned,b);}
#define WAIT_BAR(N) asm volatile("s_waitcnt vmcnt(" #N ") lgkmcnt(0)\n\ts_barrier":::"memory")

typedef __attribute__((address_space(3))) const char* lds_cptr;
typedef short v4i16_t __attribute__((ext_vector_type(4)));
__device__ __forceinline__ void kload8(bf16x8*kf,lds_cptr kp){
  kf[0]=*(const __attribute__((address_space(3))) bf16x8*)(kp);      kf[1]=*(const __attribute__((address_space(3))) bf16x8*)(kp+512);
  kf[2]=*(const __attribute__((address_space(3))) bf16x8*)(kp+2048); kf[3]=*(const __attribute__((address_space(3))) bf16x8*)(kp+2560);
  kf[4]=*(const __attribute__((address_space(3))) bf16x8*)(kp+4096); kf[5]=*(const __attribute__((address_space(3))) bf16x8*)(kp+4608);
  kf[6]=*(const __attribute__((address_space(3))) bf16x8*)(kp+6144); kf[7]=*(const __attribute__((address_space(3))) bf16x8*)(kp+6656);
}
__device__ __forceinline__ void kload2(bf16x8*kf,lds_cptr kp,int j){ kf[2*j]=*(const __attribute__((address_space(3))) bf16x8*)(kp+j*2048); kf[2*j+1]=*(const __attribute__((address_space(3))) bf16x8*)(kp+j*2048+512); }
__device__ __forceinline__ s16x4 vtr(lds_cptr p){ return __builtin_bit_cast(s16x4,__builtin_amdgcn_ds_read_tr16_b64_v4i16((__attribute__((address_space(3))) v4i16_t*)p)); }
__device__ __forceinline__ float rowmax(const f32x16&p0,const f32x16&p1){
  float a=max3f(p0[0],p0[1],p1[0]),b=max3f(p0[2],p0[3],p1[1]);a=max3f(a,p1[2],p1[3]);
  #pragma unroll
  for(int r=4;r<16;r+=4){a=max3f(a,p0[r],p0[r+1]);b=max3f(b,p0[r+2],p0[r+3]);a=max3f(a,p1[r],p1[r+1]);b=max3f(b,p1[r+2],p1[r+3]);}
  const float m=max2f(a,b);
  auto rr=__builtin_amdgcn_permlane32_swap(__float_as_uint(m),__float_as_uint(m),false,false);
  return max2f(__uint_as_float(rr[0]),__uint_as_float(rr[1]));
}
#ifndef ATTN_STORE16
#define ATTN_STORE16(p,v) (*(u32x4*)(p)=(v))
#endif
constexpr int VSLOTB=16384;
constexpr int W_K=0, W_V=NSLOT*SLOTB, W_WS=W_V+4*VSLOTB, W_OST=W_WS+NW*64*4, W_LUT=W_OST+NW*4096, W_BYTES=W_LUT+512;
static_assert(W_BYTES<=131072,"attention LDS");
__device__ __forceinline__ void qkt0(f32x16&p0,f32x16&p1,const char*Kslot,const bf16x8*qr,int r32,int hi){
  const char*kb=Kslot+hi*1024+r32*16; const f32x16 z=f32x16{};
  #pragma unroll
  for(int d0=0;d0<4;++d0){
    const bf16x8 b0=*reinterpret_cast<const bf16x8*>(kb+d0*2048);
    const bf16x8 b1=*reinterpret_cast<const bf16x8*>(kb+d0*2048+512);
    if(d0==0){p0=__builtin_amdgcn_mfma_f32_32x32x16_bf16(b0,qr[0],z,0,0,0);p1=__builtin_amdgcn_mfma_f32_32x32x16_bf16(b1,qr[0],z,0,0,0);}
    else{p0=__builtin_amdgcn_mfma_f32_32x32x16_bf16(b0,qr[d0],p0,0,0,0);p1=__builtin_amdgcn_mfma_f32_32x32x16_bf16(b1,qr[d0],p1,0,0,0);}}
}
__device__ __forceinline__ void pvw(f32x16*o,int vb,bf16x8 pa0,bf16x8 pa1,bf16x8 pa2,bf16x8 pa3){
  #pragma unroll
  for(int d0=0;d0<4;++d0){s16x4 lo[4],hi[4];
    #pragma unroll
    for(int ks=0;ks<4;++ks){
      asm volatile("ds_read_b64_tr_b16 %0,%1 offset:%c2":"=&v"(lo[ks]):"v"(vb),"i"(d0*4096+ks*1024):"memory");
      asm volatile("ds_read_b64_tr_b16 %0,%1 offset:%c2":"=&v"(hi[ks]):"v"(vb),"i"(d0*4096+ks*1024+512):"memory");}
    asm volatile("s_waitcnt lgkmcnt(0)":::"memory");SBAR();
    #define PK(k) (bf16x8){lo[k][0],lo[k][1],lo[k][2],lo[k][3],hi[k][0],hi[k][1],hi[k][2],hi[k][3]}
    o[d0]=__builtin_amdgcn_mfma_f32_32x32x16_bf16(pa0,PK(0),o[d0],0,0,0);
    o[d0]=__builtin_amdgcn_mfma_f32_32x32x16_bf16(pa1,PK(1),o[d0],0,0,0);
    o[d0]=__builtin_amdgcn_mfma_f32_32x32x16_bf16(pa2,PK(2),o[d0],0,0,0);
    o[d0]=__builtin_amdgcn_mfma_f32_32x32x16_bf16(pa3,PK(3),o[d0],0,0,0);
    #undef PK
  }
}
template<int THRL,class AX> __device__ __forceinline__ void attn_unit_w(int b,int qb,const bf16*Q,const bf16*__restrict__ K,const bf16*__restrict__ V,bf16*O,const float*rb,int hm,char*shm,bool pre,const bf16*Kn,const bf16*Vn,int bn,bool comb,int layer){
  int tid_=threadIdx.x; asm volatile("":"+v"(tid_)); const int tid=tid_,lane=tid&63,r32=lane&31,hi=lane>>5; const int wid=__builtin_amdgcn_readfirstlane(tid>>6);
  const long rowbase=(long)b*SEQ; const int q0=qb*QB;
  const bf16*Qw=Q+(rowbase+q0+wid*QBLK)*PIN;
  const bf16*Kh=K+rowbase*PIN,*Vh=V+rowbase*PIN;
  const unsigned lds0=(unsigned)(uintptr_t)shm;
  float*wsf=(float*)(shm+W_WS)+wid*64;
  const unsigned koff=(unsigned)((lane*PIN+wid*8)*2);
  const unsigned voff=(unsigned)(((16*(wid&3)+(lane>>2))*PIN+(wid>>2)*32+(lane&3)*8)*2);
  const unsigned kdst=lds0+W_K+wid*1024, vdst=lds0+W_V+wid*1024;
  #define DMA_K(t,slot) glds16s<0>(koff,Kh+(long)(t)*KVBLK*PIN,(unsigned)__builtin_amdgcn_readfirstlane(kdst+(slot)))
  #define VSL(t) ((((int)(t))&3)*VSLOTB)
  #define DMA_V(t) do{ glds16s<0>(voff,Vh+(long)(t)*KVBLK*PIN,(unsigned)__builtin_amdgcn_readfirstlane(vdst+VSL(t))); glds16s<0>(voff,(Vh+(long)(t)*KVBLK*PIN)+64,(unsigned)__builtin_amdgcn_readfirstlane(vdst+VSL(t)+8192)); }while(0)
  const int vb0=(int)(lds0+W_V)+((lane>>4)&1)*32+(lane&3)*8+(4*hi+((lane&15)>>2))*64;
  const char*Kbase=shm+W_K; bf16x8 kf[8];
  const lds_cptr shm3=(lds_cptr)shm; const lds_cptr kp0=shm3+W_K+hi*1024+r32*16; const lds_cptr vp0=shm3+W_V+((lane>>4)&1)*32+(lane&3)*8+(4*hi+((lane&15)>>2))*64;
  const __attribute__((address_space(3))) float*lut=(const __attribute__((address_space(3))) float*)(shm3+W_LUT);
  if(tid<128){ int bk=tid; if(tid>=16){ const float v=(__log2f((float)tid)-4.0f)*(16.0f/3.0f); bk=16+(int)v; bk=bk<31?bk:31; }
    ((__attribute__((address_space(3))) float*)(shm3+W_LUT))[tid]=(rb[bk*8+hm]-rb[31*8+hm])*1.4426950408889634f; }
  const int NT=(q0+QB)/KVBLK;
  if(!pre){DMA_K(0,0);}
  bf16x8 qr[4];
  #pragma unroll
  for(int d0=0;d0<4;++d0)qr[d0]=*reinterpret_cast<const bf16x8*>(&Qw[(long)r32*PIN+d0*16+hi*8]);
  float mhat=0.f,l_reg=0.f;f32x16 o[4];o[0]=f32x16{};o[1]=f32x16{};o[2]=f32x16{};o[3]=f32x16{};f32x16 negm=f32x16{};asm volatile("":"+v"(negm));
  const int qrel=wid*QBLK+r32;
  #define CMASK(P0,P1,t) do{int rel_=(t)-(NT-4); if(rel_>=-2)bmask(P0,P1,rel_,qrel,hi,lut);}while(0)
  bool resc=false;
  #define RESC() do{ if(resc){ asm volatile("s_waitcnt lgkmcnt(0)":::"memory"); \
      _Pragma("unroll") for(int d_=0;d_<4;++d_) _Pragma("unroll") for(int r=0;r<16;++r)o[d_][r]*=wsf[crow(r,hi)]; } }while(0)
  f32x16 pA0,pA1,pB0,pB1;
  int sl_prev=0,sl_cur=0,sl_next=SLOTB;
  #define ROT() do{sl_prev=sl_cur;sl_cur=sl_next;sl_next=(sl_next==(NSLOT-1)*SLOTB)?0:sl_next+SLOTB;}while(0)
  if(!pre){ DMA_V(0);DMA_K(1,SLOTB);DMA_V(1);DMA_K(2,2*SLOTB); WAIT_BAR(7); } else { WAIT_BAR(0); }
  qkt0(pA0,pA1,Kbase,qr,r32,hi);asm volatile("s_nop 15\n\ts_nop 7":"+v"(pA0),"+v"(pA1));CMASK(pA0,pA1,0);
  { const float rm=rowmax(pA0,pA1); mhat=rm;
    _Pragma("unroll") for(int r=0;r<16;++r){pA0[r]=fsub_s(pA0[r],rm);pA1[r]=fsub_s(pA1[r],rm);}
    _Pragma("unroll") for(int r=0;r<16;++r)negm[r]=-mhat; asm volatile("":"+v"(negm));
    _Pragma("unroll") for(int r=0;r<16;++r)pA0[r]=__builtin_amdgcn_exp2f(pA0[r]);
    _Pragma("unroll") for(int r=0;r<16;++r)pA1[r]=__builtin_amdgcn_exp2f(pA1[r]); }
  WAIT_BAR(3);
  DMA_K(3,0);DMA_V(2);
  ROT();
  kload8(kf,kp0+sl_cur);
  WAIT_BAR(3);
  s16x4 va_lo,va_hi,vb_lo,vb_hi,vc_lo,vc_hi,vd_lo,vd_hi,ve_lo,ve_hi; u32x4 pw0,pw1,pw2,pw3;
  #define PKW(P,B) cvtpk_s(P[B],P[B+1])
  #define PAF(k) __builtin_bit_cast(bf16x8,pw##k)
  #define VF(x) (bf16x8){x##_lo[0],x##_lo[1],x##_lo[2],x##_lo[3],x##_hi[0],x##_hi[1],x##_hi[2],x##_hi[3]}
  #define PIN(x) asm volatile("":"+v"(x))
  #define MX3(a,b,c) __builtin_fmaxf(__builtin_fmaxf((a),(b)),(c))
  #define MF32(A,B,C) __builtin_amdgcn_mfma_f32_32x32x16_bf16(A,B,C,0,0,0)
  #define GAPA(MF,A0,A1,A2,A3,W0,W1,PW) do{ MF; sacc+=A0; sacc+=A1; sacc+=A2; sacc+=A3; PIN(sacc); W0; W1; PIN(PW); SBAR(); }while(0)
  #define EX(v) __builtin_amdgcn_exp2f(v)
  #define VRW(x,i) do{ x##_lo=vtr(vp_+(((i)&3)*4096+((i)>>2)*1024)); x##_hi=vtr(vp_+(((i)&3)*4096+((i)>>2)*1024+512)); }while(0)
  #define GAPW(i,xc,xn,X,B) do{ if((i)+4<16){ VRW(xn,(i)+4); SBAR(); } o[(i)&3]=MF32(PAF_SEL(i),VF(xc),o[(i)&3]); X[B]=EX(X[B]); X[B+1]=EX(X[B+1]); PIN(X); SBAR(); }while(0)
  #define KRD(G,j) do{ if(G){ kload2(kf,kp0+sl_next,j); SBAR(); } }while(0)
  #define PAF_SEL(i) (((i)>>2)==0?PAF(0):((i)>>2)==1?PAF(1):((i)>>2)==2?PAF(2):PAF(3))
  #define STEPW(C0,C1,P0,P1,t,GK,GV,GL,PF) do{ SBAR(); \
    const lds_cptr vp_=vp0+VSL((t)-1); \
    float sacc=(P0[0]+P0[1]); \
    GAPA(C0=MF32(kf[0],qr[0],negm), P0[2],P0[3],P0[4],P0[5],     pw0[0]=PKW(P0,0), pw0[1]=PKW(P0,2), pw0); \
    GAPA(C1=MF32(kf[1],qr[0],negm), P0[6],P0[7],P0[8],P0[9],     pw0[2]=PKW(P0,4), pw0[3]=PKW(P0,6), pw0); \
    GAPA(C0=MF32(kf[2],qr[1],C0), P0[10],P0[11],P0[12],P0[13], pw1[0]=PKW(P0,8), pw1[1]=PKW(P0,10), pw1); \
    GAPA(C1=MF32(kf[3],qr[1],C1), P0[14],P0[15],P1[0],P1[1],   pw1[2]=PKW(P0,12),pw1[3]=PKW(P0,14), pw1); \
    GAPA(C0=MF32(kf[4],qr[2],C0), P1[2],P1[3],P1[4],P1[5],     pw2[0]=PKW(P1,0), pw2[1]=PKW(P1,2), pw2); \
    GAPA(C1=MF32(kf[5],qr[2],C1), P1[6],P1[7],P1[8],P1[9],     pw2[2]=PKW(P1,4), pw2[3]=PKW(P1,6), pw2); \
    GAPA(C0=MF32(kf[6],qr[3],C0), P1[10],P1[11],P1[12],P1[13], pw3[0]=PKW(P1,8), pw3[1]=PKW(P1,10), pw3); \
    GAPA(C1=MF32(kf[7],qr[3],C1), P1[14],P1[15],0.f,0.f,       pw3[2]=PKW(P1,12),pw3[3]=PKW(P1,14), pw3); \
    l_reg+=sacc; \
    VRW(va,0); VRW(vb,1); VRW(vc,2); VRW(vd,3); SBAR(); \
    CMASK(C0,C1,t); \
    { float a=MX3(C0[0],C0[1],C1[0]),b=MX3(C0[2],C0[3],C1[1]); a=MX3(a,C1[2],C1[3]); \
      _Pragma("unroll") for(int r=4;r<16;r+=4){a=MX3(a,C0[r],C0[r+1]);b=MX3(b,C0[r+2],C0[r+3]);a=MX3(a,C1[r],C1[r+1]);b=MX3(b,C1[r+2],C1[r+3]);} \
      float rm=__builtin_fmaxf(a,b); { auto rr=__builtin_amdgcn_permlane32_swap(__float_as_uint(rm),__float_as_uint(rm),false,false); rm=__builtin_fmaxf(__uint_as_float(rr[0]),__uint_as_float(rr[1])); } \
      resc=false; \
      if(__builtin_expect(__any(rm>(float)THRL),0)){ const float dl=__builtin_fmaxf(rm,0.f); mhat+=dl; \
        _Pragma("unroll") for(int r=0;r<16;++r){C0[r]-=dl;C1[r]-=dl;} \
        _Pragma("unroll") for(int r=0;r<16;++r)negm[r]=-mhat; asm volatile("":"+v"(negm)); \
        const float f=__builtin_amdgcn_exp2f(-dl); l_reg*=f; if(hi==0)wsf[r32]=f; resc=true; } } \
    if(GK){DMA_K((t)+3,sl_cur);} if(GV){DMA_V((t)+2);} \
    if(PF){ if(Kn){ const bf16*ksn=Kn+(long)bn*SEQ*PIN; const bf16*vsn=Vn+(long)bn*SEQ*PIN; \
        glds16s<0>(koff,ksn,(unsigned)__builtin_amdgcn_readfirstlane(kdst)); glds16s<0>(koff,ksn+(long)KVBLK*PIN,(unsigned)__builtin_amdgcn_readfirstlane(kdst+SLOTB)); glds16s<0>(koff,ksn+(long)2*KVBLK*PIN,(unsigned)__builtin_amdgcn_readfirstlane(kdst+2*SLOTB)); \
        glds16s<0>(voff,vsn,(unsigned)__builtin_amdgcn_readfirstlane(vdst)); glds16s<0>(voff,(vsn)+64,(unsigned)__builtin_amdgcn_readfirstlane(vdst+8192)); \
        glds16s<0>(voff,vsn+(long)KVBLK*PIN,(unsigned)__builtin_amdgcn_readfirstlane(vdst+VSLOTB)); glds16s<0>(voff,(vsn+(long)KVBLK*PIN)+64,(unsigned)__builtin_amdgcn_readfirstlane(vdst+VSLOTB+8192)); } } \
    SBAR(); \
    GAPW(0,va,ve,C0,0); GAPW(1,vb,va,C0,2); GAPW(2,vc,vb,C0,4); GAPW(3,vd,vc,C0,6); \
    KRD(GL,0); GAPW(4,ve,vd,C0,8); GAPW(5,va,ve,C0,10); KRD(GL,1); GAPW(6,vb,va,C0,12); GAPW(7,vc,vb,C0,14); \
    KRD(GL,2); GAPW(8,vd,vc,C1,0); GAPW(9,ve,vd,C1,2); KRD(GL,3); GAPW(10,va,ve,C1,4); GAPW(11,vb,va,C1,6); \
    GAPW(12,vc,vb,C1,8); GAPW(13,vd,vc,C1,10); GAPW(14,ve,vd,C1,12); GAPW(15,va,ve,C1,14); \
    }while(0)
  int t=1;
  #undef CMASK
  #define CMASK(P0,P1,t) do{}while(0)
  for(;t+7<NT;t+=2){
    STEPW(pB0,pB1,pA0,pA1,t,true,true,true,false);     WAIT_BAR(5); RESC(); ROT();
    STEPW(pA0,pA1,pB0,pB1,t+1,true,true,true,false);   WAIT_BAR(5); RESC(); ROT();
  }
  #undef CMASK
  #define CMASK(P0,P1,t) do{int rel_=(t)-(NT-4); if(rel_>=-2)bmask(P0,P1,rel_,qrel,hi,lut);}while(0)
  #define ENDW(tt) do{ if((tt)+3<NT){WAIT_BAR(5);} else if((tt)+2<NT){WAIT_BAR(4);} else {WAIT_BAR(0);} }while(0)
  for(;t+1<NT;t+=2){
    STEPW(pB0,pB1,pA0,pA1,t,(t+3<NT),(t+2<NT),(t+1<NT),false);       ENDW(t);   RESC(); ROT();
    STEPW(pA0,pA1,pB0,pB1,t+1,(t+4<NT),(t+3<NT),(t+2<NT),false);     ENDW(t+1); RESC(); ROT();
  }
  STEPW(pB0,pB1,pA0,pA1,NT-1,false,false,false,true); RESC();
  bf16*Ow=O+(rowbase+q0+wid*QBLK)*POUT; int ln_=lane; asm volatile("":"+v"(ln_)); const int ch=ln_&7,rw_=ln_>>3; u32x4 z0[2][4];
  if(comb){ const bf16*O0w=Ow+AX::O0_OFF;
    #pragma unroll
    for(int hf=0;hf<2;++hf)
      #pragma unroll
      for(int i=0;i<4;++i){const int row=i*8+rw_; z0[hf][i]=*(const u32x4*)(O0w+(long)row*POUT+hf*64+ch*8);} }
  { float sacc=pB0[0]+pB0[1]; _Pragma("unroll") for(int r=2;r<16;++r)sacc+=pB0[r]; _Pragma("unroll") for(int r=0;r<16;++r)sacc+=pB1[r]; l_reg+=sacc;
    pw0=(u32x4){PKW(pB0,0),PKW(pB0,2),PKW(pB0,4),PKW(pB0,6)};pw1=(u32x4){PKW(pB0,8),PKW(pB0,10),PKW(pB0,12),PKW(pB0,14)};pw2=(u32x4){PKW(pB1,0),PKW(pB1,2),PKW(pB1,4),PKW(pB1,6)};pw3=(u32x4){PKW(pB1,8),PKW(pB1,10),PKW(pB1,12),PKW(pB1,14)};
    SBAR(); pvw(o,vb0+VSL(NT-1),PAF(0),PAF(1),PAF(2),PAF(3)); }
  #undef PKW
  #undef PAF
  #undef VF
  #undef PIN
  #undef MX3
  #undef MF32
  #undef GAPA
  #undef GAPW
  #undef EX
  #undef VRW
  #undef KRD
  #undef PAF_SEL
  #undef STEPW
  #undef ENDW
  {auto rr=__builtin_amdgcn_permlane32_swap(__float_as_uint(l_reg),__float_as_uint(l_reg),false,false);l_reg=__uint_as_float(rr[0])+__uint_as_float(rr[1]);}
  if(hi==0)wsf[32+r32]=l_reg;asm volatile("s_waitcnt lgkmcnt(0)":::"memory");
  float rli[16];
  #pragma unroll
  for(int r=0;r<16;++r)rli[r]=__builtin_amdgcn_rcpf(wsf[32+crow(r,hi)]);
  if(!comb){
  #pragma unroll
  for(int hf=0;hf<2;++hf){ bf16*stg=(bf16*)(shm+W_OST)+wid*2048;
    #pragma unroll
    for(int r=0;r<16;++r){const int orow=crow(r,hi);
      #pragma unroll
      for(int d0=0;d0<2;++d0)stg[orow*64+d0*32+r32]=__float2bfloat16(o[2*hf+d0][r]*rli[r]);}
    asm volatile("s_waitcnt lgkmcnt(0)":::"memory");
    #pragma unroll
    for(int i=0;i<4;++i){const int row=i*8+(lane>>3),ch=lane&7; const u32x4 v=*(const u32x4*)(stg+row*64+ch*8); ATTN_STORE16(Ow+(long)row*POUT+hf*64+ch*8,v);}
    asm volatile("s_waitcnt lgkmcnt(0)":::"memory"); }
  } else {
    int ly=layer; asm volatile("":"+s"(ly));
    const float lam=AX::lam(ly,lane),post=AX::post(ly); const float*sg=AX::sg(ly);
    u32x4 z1[2][4];
    float g[2][8];
    #pragma unroll
    for(int hf=0;hf<2;++hf)
      #pragma unroll
      for(int k=0;k<8;++k)g[hf][k]=sg[hf*64+ch*8+k];
    #pragma unroll
    for(int hf=0;hf<2;++hf){ bf16*stg=(bf16*)(shm+W_OST)+wid*2048;
      #pragma unroll
      for(int r=0;r<16;++r){const int orow=crow(r,hi);
        #pragma unroll
        for(int d0=0;d0<2;++d0)stg[orow*64+d0*32+r32]=__float2bfloat16(o[2*hf+d0][r]*rli[r]);}
      asm volatile("s_waitcnt lgkmcnt(0)":::"memory");
      #pragma unroll
      for(int i=0;i<4;++i){const int row=i*8+rw_; z1[hf][i]=*(const u32x4*)(stg+row*64+ch*8);}
      asm volatile("s_waitcnt lgkmcnt(0)":::"memory"); }
    #pragma unroll
    for(int i=0;i<4;++i){const int row=i*8+rw_;
      float d[2][8]; float ss=0.f;
      #pragma unroll
      for(int hf=0;hf<2;++hf)
        #pragma unroll
        for(int k=0;k<4;++k){ const unsigned a=z0[hf][i][k],c=z1[hf][i][k];
          d[hf][2*k]=__uint_as_float(a<<16)-lam*__uint_as_float(c<<16); d[hf][2*k+1]=__uint_as_float(a&0xffff0000u)-lam*__uint_as_float(c&0xffff0000u);
          ss+=d[hf][2*k]*d[hf][2*k]+d[hf][2*k+1]*d[hf][2*k+1]; }
      ss+=__shfl_xor(ss,1); ss+=__shfl_xor(ss,2); ss+=__shfl_xor(ss,4);
      const float rn=post/sqrtf(ss*(1.f/128.f)+1e-6f);
      #pragma unroll
      for(int hf=0;hf<2;++hf){ u32x4 w;
        #pragma unroll
        for(int k=0;k<4;++k)w[k]=cvtpk_s(d[hf][2*k]*rn*g[hf][2*k],d[hf][2*k+1]*rn*g[hf][2*k+1]);
        ATTN_STORE16(Ow+(long)row*POUT+hf*64+ch*8,w); } }
  }
  asm volatile("s_waitcnt lgkmcnt(0)\n\ts_barrier":::"memory");
  #undef DMA_K
  #undef DMA_V
  #undef VSL
  #undef CMASK
  #undef RESC
  #undef ROT
}
template<int THRL,class AX> __device__ __forceinline__ void attn_phase_w(char*lds,const bf16*P,bf16*O,bf16*Y,const float*rb,int vcu,int layer,unsigned*qbase,volatile __attribute__((address_space(3))) unsigned*slot){
  const int s=vcu&7,bh=vcu>>3,b0=bh>>2;
  int cur=31-s,h=bh&3,b=b0,k=1; bool pre=false;
  while(cur>=0){ int nxt,hn=h,bn=b;
    attn_unit_w<THRL,AX>(b,cur,P+0+(2*h)*64,P+512+(2*h)*64,P+1024+h*128,O+h*128,rb,h*2,lds,pre,P+512+(2*h+1)*64,P+1024+h*128,b,false,layer);
    if(k==1)nxt=16+s;
    else{ int d=64;
      for(int j=0;j<8&&d>=64;++j){ bn=(b0+j)&7; if(threadIdx.x==0)*slot=__hip_atomic_fetch_add(qbase+bn*32,1u,__ATOMIC_RELAXED,__HIP_MEMORY_SCOPE_AGENT); __syncthreads(); d=(int)__builtin_amdgcn_readfirstlane((int)*slot); __syncthreads(); }
      nxt=d<64?15-(d>>2):-1; hn=d&3; }
    ++k;
    attn_unit_w<THRL,AX>(b,cur,P+0+(2*h+1)*64,P+512+(2*h+1)*64,P+1024+h*128,Y+h*128,rb,h*2+1,lds,true,(nxt>=0)?P+512+(2*hn)*64:nullptr,P+1024+hn*128,bn,true,layer);
    pre=true; cur=nxt; h=hn; b=bn; }
}
#undef SBAR
#undef WAIT_BAR
}

namespace ret {
typedef short bf16x8 __attribute__((ext_vector_type(8)));
typedef short bf16x4 __attribute__((ext_vector_type(4)));
typedef float f32x16 __attribute__((ext_vector_type(16)));
typedef unsigned u32x4 __attribute__((ext_vector_type(4)));
typedef float f32x4 __attribute__((ext_vector_type(4)));
typedef float f32x2 __attribute__((ext_vector_type(2)));
#define RLAS __attribute__((address_space(3)))
constexpr int QPB = 144, VPB = 272;
constexpr int R3_QL = 0, R3_KL = 18432, R3_VT = 36864, R3_ST = 54272, R3_STAT = 63488, R3_YS = 65536, YSP = 68;
constexpr int R1_KT = 0, R1_VT = 17408, R1_RED = 34816;
__device__ __forceinline__ int crow(int r, int hi) { return (r & 3) + 8 * (r >> 2) + 4 * hi; }
__device__ __forceinline__ unsigned pkbf(float lo, float hi) { typedef float v2f __attribute__((ext_vector_type(2))); typedef __bf16 v2b __attribute__((ext_vector_type(2))); v2f v = {lo, hi}; v2b b = __builtin_convertvector(v, v2b); return __builtin_bit_cast(unsigned, b); }
__device__ __forceinline__ void put_transposed(RLAS unsigned char* img, int dim0, int token, u32x4 w) {
    RLAS unsigned short* p = (RLAS unsigned short*)(img + dim0 * VPB + token * 2);
    p[0 * (VPB / 2)] = (unsigned short)w.x; p[1 * (VPB / 2)] = (unsigned short)(w.x >> 16); p[2 * (VPB / 2)] = (unsigned short)w.y; p[3 * (VPB / 2)] = (unsigned short)(w.y >> 16);
    p[4 * (VPB / 2)] = (unsigned short)w.z; p[5 * (VPB / 2)] = (unsigned short)(w.z >> 16); p[6 * (VPB / 2)] = (unsigned short)w.w; p[7 * (VPB / 2)] = (unsigned short)(w.w >> 16);
}
__device__ __forceinline__ void ret_kv_units(RLAS unsigned char* lds, const unsigned short* P, float* AT, int u0, int ustep, int nunits) {
    int tid = threadIdx.x; asm volatile("" : "+v"(tid)); const int lane = tid & 63, wave = __builtin_amdgcn_readfirstlane(tid >> 6), r32 = lane & 31, hi = lane >> 5;
    const int tl = wave & 3, eb = tl >> 1, db = tl & 1, kh = wave >> 2;
    u32x4 kw[2], vw[2];
#define RKV_LOAD(unit_) do { const int c_ = (unit_) & 63, h_ = ((unit_) >> 6) & 3, b_ = (unit_) >> 8; const size_t row0_ = (size_t)b_ * 8192 + (size_t)c_ * 128; \
        _Pragma("unroll") for (int jx = 0; jx < 2; ++jx) { const int ci = tid + 512 * jx, token = ci & 127, c8 = ci >> 7; \
            kw[jx] = *(const u32x4*)(P + (row0_ + token) * 2816 + 2048 + h_ * 64 + c8 * 8); vw[jx] = *(const u32x4*)(P + (row0_ + token) * 2816 + 2304 + h_ * 64 + c8 * 8); } } while (0)
    if (u0 < nunits) RKV_LOAD(u0);
    for (int unit = u0; unit < nunits; unit += ustep) {
        __syncthreads();
#pragma unroll
        for (int jx = 0; jx < 2; ++jx) { const int ci = tid + 512 * jx, token = ci & 127, c8 = ci >> 7;
            put_transposed(lds + R1_KT, c8 * 8, token, kw[jx]); put_transposed(lds + R1_VT, c8 * 8, token, vw[jx]); }
        if (unit + ustep < nunits) RKV_LOAD(unit + ustep);
        __syncthreads();
        f32x16 acc = {};
#pragma unroll
        for (int s = 0; s < 4; ++s) { const int ks = kh * 4 + s;
            const bf16x8 a = *(const RLAS bf16x8*)(lds + R1_VT + (32 * eb + r32) * VPB + (16 * ks + 8 * hi) * 2);
            const bf16x8 bb = *(const RLAS bf16x8*)(lds + R1_KT + (32 * db + r32) * VPB + (16 * ks + 8 * hi) * 2);
            acc = __builtin_amdgcn_mfma_f32_32x32x16_bf16(a, bb, acc, 0, 0, 0); }
        RLAS f32x4* red = (RLAS f32x4*)(lds + R1_RED + tl * 4096) + lane * 4;
        if (kh == 1) { red[0] = (f32x4){acc[0], acc[1], acc[2], acc[3]}; red[1] = (f32x4){acc[4], acc[5], acc[6], acc[7]}; red[2] = (f32x4){acc[8], acc[9], acc[10], acc[11]}; red[3] = (f32x4){acc[12], acc[13], acc[14], acc[15]}; }
        __syncthreads();
        if (kh == 0) { float* out = AT + (size_t)unit * 4096 + 32 * db + r32;
#pragma unroll
            for (int q = 0; q < 4; ++q) { const f32x4 o = red[q];
#pragma unroll
                for (int x = 0; x < 4; ++x) { const int r = 4 * q + x; out[(32 * eb + crow(r, hi)) * 64] = acc[r] + o[x]; } } }
    }
#undef RKV_LOAD
}
__device__ __forceinline__ void ret_out_unit(RLAS unsigned char* lds, const unsigned short* P, unsigned short* Y, const float* AT, const float* gn_g  , int unit) {
    int tid = threadIdx.x; asm volatile("" : "+v"(tid)); const int lane = tid & 63, wave = __builtin_amdgcn_readfirstlane(tid >> 6), r32 = lane & 31, hi = lane >> 5;
    const int g = unit & 7, h = (unit >> 3) & 3, b = unit >> 5;
    const float lg = pg8::lg2_gamma(h), gamma = __builtin_amdgcn_exp2f(lg), g127 = __builtin_amdgcn_exp2f(127.0f * lg), g128 = __builtin_amdgcn_exp2f(128.0f * lg);
    const size_t rowb = (size_t)b * 8192;
    const float* ATh = AT + (size_t)((b * 4 + h) * 64) * 4096 + tid * 8;
    u32x4 qreg[2], kreg[2], vreg[2];
#pragma unroll
    for (int jx = 0; jx < 2; ++jx) { const int ci = tid + 512 * jx; const size_t rq = rowb + (size_t)(8 * g) * 128 + (ci >> 3), rv = rowb + (size_t)(8 * g) * 128 + (ci & 127);
        qreg[jx] = *(const u32x4*)(P + rq * 2816 + 1792 + h * 64 + (ci & 7) * 8); kreg[jx] = *(const u32x4*)(P + rq * 2816 + 2048 + h * 64 + (ci & 7) * 8);
        vreg[jx] = *(const u32x4*)(P + rv * 2816 + 2304 + h * 64 + (ci >> 7) * 8); }
    float S[8];
#pragma unroll
    for (int x = 0; x < 8; ++x) S[x] = 0.f;
#pragma unroll 8
    for (int cp = 0; cp < 8 * g; ++cp) { const f32x4 a0 = *(const f32x4*)(ATh + (size_t)cp * 4096), a1 = *(const f32x4*)(ATh + (size_t)cp * 4096 + 4);
        S[0] = g128 * S[0] + g127 * a0[0]; S[1] = g128 * S[1] + g127 * a0[1]; S[2] = g128 * S[2] + g127 * a0[2]; S[3] = g128 * S[3] + g127 * a0[3];
        S[4] = g128 * S[4] + g127 * a1[0]; S[5] = g128 * S[5] + g127 * a1[1]; S[6] = g128 * S[6] + g127 * a1[2]; S[7] = g128 * S[7] + g127 * a1[3]; }
    const int ib = wave >> 1, eh = wave & 1;
    for (int cc = 0; cc < 8; ++cc) {
        const int c = 8 * g + cc; const size_t row0 = rowb + (size_t)c * 128;
        const f32x4 n0 = *(const f32x4*)(ATh + (size_t)c * 4096), n1 = *(const f32x4*)(ATh + (size_t)c * 4096 + 4);
        u32x4 sgr[2];
#pragma unroll
        for (int jx = 0; jx < 2; ++jx) { const int ci = tid + 512 * jx; sgr[jx] = *(const u32x4*)(P + (row0 + (ci >> 3)) * 2816 + 2560 + h * 64 + (ci & 7) * 8); }
        __syncthreads();
#pragma unroll
        for (int jx = 0; jx < 2; ++jx) { const int ci = tid + 512 * jx;
            { const int row = ci >> 3, c8 = ci & 7; *(RLAS u32x4*)(lds + R3_QL + row * QPB + c8 * 16) = qreg[jx]; *(RLAS u32x4*)(lds + R3_KL + row * QPB + c8 * 16) = kreg[jx]; }
            { const int token = ci & 127, c8 = ci >> 7; put_transposed(lds + R3_VT, c8 * 8, token, vreg[jx]); } }
        { u32x4 sw; sw.x = pkbf(gamma * S[0], gamma * S[1]); sw.y = pkbf(gamma * S[2], gamma * S[3]); sw.z = pkbf(gamma * S[4], gamma * S[5]); sw.w = pkbf(gamma * S[6], gamma * S[7]);
          *(RLAS u32x4*)(lds + R3_ST + (tid >> 3) * QPB + (tid & 7) * 16) = sw; }
        if (cc < 7) {
#pragma unroll
            for (int jx = 0; jx < 2; ++jx) { const int ci = tid + 512 * jx; const size_t rq = row0 + 128 + (ci >> 3), rv = row0 + 128 + (ci & 127);
                qreg[jx] = *(const u32x4*)(P + rq * 2816 + 1792 + h * 64 + (ci & 7) * 8); kreg[jx] = *(const u32x4*)(P + rq * 2816 + 2048 + h * 64 + (ci & 7) * 8);
                vreg[jx] = *(const u32x4*)(P + rv * 2816 + 2304 + h * 64 + (ci >> 7) * 8); } }
        __syncthreads();
        bf16x8 bq[4];
#pragma unroll
        for (int ks = 0; ks < 4; ++ks) bq[ks] = *(const RLAS bf16x8*)(lds + R3_QL + (32 * ib + r32) * QPB + (16 * ks + 8 * hi) * 2);
        f32x16 yt = {};
        for (int jb = 0; jb <= ib; ++jb) {
            f32x16 x = {};
#pragma unroll
            for (int ks = 0; ks < 4; ++ks) { const bf16x8 ka = *(const RLAS bf16x8*)(lds + R3_KL + (32 * jb + r32) * QPB + (16 * ks + 8 * hi) * 2); x = __builtin_amdgcn_mfma_f32_32x32x16_bf16(ka, bq[ks], x, 0, 0, 0); }
            if (jb == ib) {
#pragma unroll
                for (int r = 0; r < 16; ++r) if (crow(r, hi) > r32) x[r] = 0.f; }
#pragma unroll
            for (int s = 0; s < 2; ++s) {
                u32x4 xw; xw.x = pkbf(x[8 * s], x[8 * s + 1]); xw.y = pkbf(x[8 * s + 2], x[8 * s + 3]); xw.z = pkbf(x[8 * s + 4], x[8 * s + 5]); xw.w = pkbf(x[8 * s + 6], x[8 * s + 7]);
                const RLAS unsigned char* vp = lds + R3_VT + (32 * eh + r32) * VPB + (32 * jb + 16 * s + 4 * hi) * 2;
                const bf16x4 v0 = *(const RLAS bf16x4*)vp, v1 = *(const RLAS bf16x4*)(vp + 16);
                const bf16x8 va = {v0[0], v0[1], v0[2], v0[3], v1[0], v1[1], v1[2], v1[3]};
                yt = __builtin_amdgcn_mfma_f32_32x32x16_bf16(va, __builtin_bit_cast(bf16x8, xw), yt, 0, 0, 0); }
        }
#pragma unroll
        for (int ks = 0; ks < 4; ++ks) { const bf16x8 sa = *(const RLAS bf16x8*)(lds + R3_ST + (32 * eh + r32) * QPB + (16 * ks + 8 * hi) * 2); yt = __builtin_amdgcn_mfma_f32_32x32x16_bf16(sa, bq[ks], yt, 0, 0, 0); }
        float s1 = 0.f, s2 = 0.f;
#pragma unroll
        for (int r = 0; r < 16; ++r) { s1 += yt[r]; s2 += yt[r] * yt[r]; }
        s1 += __shfl_xor(s1, 32); s2 += __shfl_xor(s2, 32);
        RLAS f32x2* stat = (RLAS f32x2*)(lds + R3_STAT);
        if (hi == 0) stat[eh * 128 + 32 * ib + r32] = (f32x2){s1, s2};
        __syncthreads();
        { const f32x2 sa = stat[32 * ib + r32], sb = stat[128 + 32 * ib + r32];
          const float mean = (sa.x + sb.x) * (1.f / 64.f), var = fmaxf((sa.y + sb.y) * (1.f / 64.f) - mean * mean, 0.f), rstd = 1.0f / sqrtf(var + 1e-6f);
          RLAS float* ys = (RLAS float*)(lds + R3_YS) + (32 * ib + r32) * YSP + 32 * eh;
#pragma unroll
          for (int r = 0; r < 16; ++r) ys[crow(r, hi)] = (yt[r] - mean) * rstd; }
        S[0] = g128 * S[0] + g127 * n0[0]; S[1] = g128 * S[1] + g127 * n0[1]; S[2] = g128 * S[2] + g127 * n0[2]; S[3] = g128 * S[3] + g127 * n0[3];
        S[4] = g128 * S[4] + g127 * n1[0]; S[5] = g128 * S[5] + g127 * n1[1]; S[6] = g128 * S[6] + g127 * n1[2]; S[7] = g128 * S[7] + g127 * n1[3];
        __syncthreads();
#pragma unroll
        for (int jx = 0; jx < 2; ++jx) { const int ci = tid + 512 * jx, row = ci >> 3, c8 = ci & 7;
            const RLAS float* ys = (const RLAS float*)(lds + R3_YS) + row * YSP + c8 * 8; const f32x4 y0 = *(const RLAS f32x4*)ys, y1 = *(const RLAS f32x4*)(ys + 4);
            const f32x4 g0 = *(const f32x4*)(gn_g + h * 64 + c8 * 8), g1 = *(const f32x4*)(gn_g + h * 64 + c8 * 8 + 4);
            const u32x4 sg = sgr[jx];
            u32x4 o;
            o.x = pkbf(y0[0] * g0[0] * __uint_as_float(sg.x << 16), y0[1] * g0[1] * __uint_as_float(sg.x & 0xffff0000u)); o.y = pkbf(y0[2] * g0[2] * __uint_as_float(sg.y << 16), y0[3] * g0[3] * __uint_as_float(sg.y & 0xffff0000u));
            o.z = pkbf(y1[0] * g1[0] * __uint_as_float(sg.z << 16), y1[1] * g1[1] * __uint_as_float(sg.z & 0xffff0000u)); o.w = pkbf(y1[2] * g1[2] * __uint_as_float(sg.w << 16), y1[3] * g1[3] * __uint_as_float(sg.w & 0xffff0000u));
            *(u32x4*)(Y + (row0 + row) * 1024 + 768 + h * 64 + c8 * 8) = o; }
    }
}
#undef RLAS
}
#define GAS __attribute__((address_space(1)))
#define LAS __attribute__((address_space(3)))
typedef unsigned short bf16;
typedef unsigned v4u __attribute__((ext_vector_type(4)));
typedef float f32x4 __attribute__((ext_vector_type(4)));
typedef short bf16x8 __attribute__((ext_vector_type(8)));
typedef GAS unsigned gu32;
typedef GAS unsigned long long gu64;
#define RLX_AGENT __ATOMIC_RELAXED, __HIP_MEMORY_SCOPE_AGENT
#define LDS_WAIT() asm volatile("s_waitcnt lgkmcnt(0)" ::: "memory")
#define VM_WAIT() asm volatile("s_waitcnt vmcnt(0)" ::: "memory")
__device__ __forceinline__ unsigned long long rt() { return __builtin_amdgcn_s_memrealtime(); }
__device__ __forceinline__ unsigned f2bf(float f) { unsigned u = __builtin_bit_cast(unsigned, f); return (u + 0x7fffu + ((u >> 16) & 1u)) >> 16; }
__device__ __forceinline__ unsigned pk2(float lo, float hi) { return f2bf(lo) | (f2bf(hi) << 16); }

#define XB_TMO      128
#define XB_XCNT(j)  (256  + 64 * (j))
#define XB_XSUB(j)  (1280 + 64 * (j))
#define XB_XGEN(j)  (2304 + 64 * (j))
#define XB_TOP      3328
#define XB_TOPGEN   3392
#define XCD_BAR_WORDS 3456
#define XB_SPIN_CAP (1u << 22)

__device__ __forceinline__ unsigned xb_ld(unsigned* p)              { return __hip_atomic_load(p, __ATOMIC_RELAXED, __HIP_MEMORY_SCOPE_AGENT); }
__device__ __forceinline__ unsigned xb_add(unsigned* p, unsigned v) { return __hip_atomic_fetch_add(p, v, __ATOMIC_RELAXED, __HIP_MEMORY_SCOPE_AGENT); }
__device__ __forceinline__ unsigned xb_xcc_id() { return (unsigned)__builtin_amdgcn_s_getreg((3 << 11) | 20) & 0xFu; }
#define XB_SPIN(cond, bar) do { unsigned _sp = 0; while (cond) { __builtin_amdgcn_s_sleep(1); \
    if ((++_sp & 255u) == 0u) { if (xb_ld(&(bar)[XB_TMO])) break; if (_sp > XB_SPIN_CAP) { atomicAdd(&(bar)[XB_TMO], 1u); break; } } } } while (0)

struct XcdBarrier {
    unsigned* bar; unsigned x;
    volatile LAS unsigned* st;
};

__device__ __forceinline__ XcdBarrier xcd_barrier_post(unsigned* bar, volatile LAS unsigned* st) {
    XcdBarrier b; b.bar = bar; b.x = xb_xcc_id(); b.st = st;
    if (threadIdx.x == 0) (void)xb_add(&bar[XB_XCNT(b.x)], 1u);
    return b;
}
__device__ __forceinline__ void xcd_barrier_complete(unsigned* bar, unsigned x, unsigned& nloc, unsigned& nx) {
    const unsigned G = gridDim.x * gridDim.y * gridDim.z;
    unsigned sum, cnt, mine, sp = 0u;
    for (;;) {
        sum = 0u; cnt = 0u; mine = 0u;
#pragma unroll
        for (unsigned j = 0; j < 16; ++j) { const unsigned c = xb_ld(&bar[XB_XCNT(j)]); sum += c; cnt += (c > 0u) ? 1u : 0u; mine = (j == x) ? c : mine; }
        if (sum == G) break;
        __builtin_amdgcn_s_sleep(1);
        if ((++sp & 255u) == 0u) { if (xb_ld(&bar[XB_TMO])) break; if (sp > XB_SPIN_CAP) { atomicAdd(&bar[XB_TMO], 1u); break; } }
    }
    nloc = mine > 0u ? mine : 1u; nx = cnt > 0u ? cnt : 1u;
}

__device__ __forceinline__ void xcd_barrier(const XcdBarrier& b) {
    asm volatile("s_waitcnt vmcnt(0)" ::: "memory");
    __syncthreads();
    if (threadIdx.x == 0) {
#ifdef PROBE_BARWAIT
        const unsigned long long pbw_t0 = __builtin_amdgcn_s_memrealtime();
#endif
        unsigned* bar = b.bar;
        __builtin_amdgcn_s_waitcnt(0);
        unsigned nloc = b.st[0], nx = b.st[1];
        if (nloc == 0u) { xcd_barrier_complete(bar, b.x, nloc, nx); b.st[0] = nloc; b.st[1] = nx; }
        const unsigned old = xb_add(&bar[XB_XSUB(b.x)], 1u);
        const unsigned gen = old / nloc;
        if (old + 1u == (gen + 1u) * nloc) {
            __builtin_amdgcn_fence(__ATOMIC_RELEASE, "agent");
            asm volatile("s_waitcnt vmcnt(0)" ::: "memory");
            const unsigned og = xb_add(&bar[XB_TOP], 1u);
            const unsigned tg = og / nx;
            if (og + 1u == (tg + 1u) * nx) xb_add(&bar[XB_TOPGEN], 1u);
            else XB_SPIN(xb_ld(&bar[XB_TOPGEN]) == tg, bar);
            __builtin_amdgcn_fence(__ATOMIC_ACQUIRE, "agent");
            xb_add(&bar[XB_XGEN(b.x)], 1u);
            asm volatile("s_waitcnt vmcnt(0)" ::: "memory");
        } else {
            XB_SPIN(xb_ld(&bar[XB_XGEN(b.x)]) == gen, bar);
            __builtin_amdgcn_fence(__ATOMIC_ACQUIRE, "agent");
            asm volatile("s_waitcnt vmcnt(0)" ::: "memory");
        }
#ifdef PROBE_BARWAIT
        { const unsigned j_ = b.st[9]; b.st[9] = j_ + 1u; if ((PROBE_BARMASK >> j_) & 1u) b.st[8] += (unsigned)(__builtin_amdgcn_s_memrealtime() - pbw_t0); }
#endif
    }
    __syncthreads();
}

constexpr int NWAVES = 8, NTHR = NWAVES * 64;
constexpr int BATCH = 8, SEQ = 8192, DM = 1024, MROWS = BATCH * SEQ;
constexpr int INW = 2816, FFD = 2816, NEXP = 8, EDIM = 3584, DEPTH = 2;
constexpr int PC_Q = 0, PC_K = 512, PC_V = 1024, PC_POOL = 1536, PC_RQ = 1792, PC_RK = 2048, PC_RV = 2304, PC_RG = 2560;
constexpr float LN_EPS = 1e-5f, NORM_EPS = 1e-6f, ALPHA = 1.4142135623730951f, LOG2E = 1.4426950408889634f;
constexpr int QTILES = 192, QLAST = 128, QMID_MAX = 200;
constexpr int MAXTILES = (MROWS * 2) / 256 + NEXP;

constexpr size_t MiB = 1u << 20;
constexpr size_t WS_CTL = 0, CTL_ZERO_BYTES = 1 * MiB;
constexpr size_t WS_RE = 1 * MiB;
constexpr size_t WS_RG = WS_RE + 512 * 1024;
constexpr size_t WS_RS = WS_RG + 512 * 1024;
constexpr size_t WS_BC = WS_RS + 512 * 1024;
constexpr size_t WS_MI = WS_BC + 16 * 1024;
constexpr size_t WS_W = 8 * MiB;
constexpr size_t WS_WIN = WS_W;
constexpr size_t WS_WOUT = WS_WIN + 2 * (size_t)INW * DM * 2;
constexpr size_t WS_WGU = WS_WOUT + 2 * (size_t)DM * DM * 2;
constexpr size_t WS_WD = WS_WGU + 2 * (size_t)FFD * DM * 2;
constexpr size_t WS_MGU = WS_WD + (size_t)FFD * DM * 2;
constexpr size_t WS_MD = WS_MGU + (size_t)NEXP * 2 * EDIM * DM * 2;
constexpr size_t WS_WEND = WS_MD + (size_t)NEXP * EDIM * DM * 2;
constexpr size_t WS_XB = 208 * MiB;
constexpr size_t WS_Y = 336 * MiB;
constexpr size_t WS_P = 464 * MiB;
constexpr size_t WS_O = 816 * MiB;
constexpr size_t WS_AT = 944 * MiB;
constexpr size_t WS_END = 976 * MiB;
constexpr size_t WS_HQ = WS_XB;
constexpr size_t WS_HQ8 = WS_XB;
constexpr size_t WS_HQ8B = 636 * MiB;
constexpr size_t WS_XG8 = 376 * MiB;
constexpr size_t WS_XG = 506 * MiB;
static_assert(WS_WEND <= WS_XB, "weights fit");
static_assert(QTILES + QMID_MAX + QLAST >= MAXTILES && MAXTILES - NEXP - QTILES - QLAST == QTILES, "chunks cover every row tile");
static_assert((size_t)MAXTILES * 256 * DM * 2 <= WS_O - WS_P, "slot rows fit");
static_assert(WS_HQ8 + (size_t)QTILES * 256 * EDIM <= WS_XG8 && WS_XG8 + (size_t)MAXTILES * 256 * DM <= WS_XG && WS_XG + (size_t)MAXTILES * 256 * DM <= WS_HQ8B && WS_HQ8B + (size_t)QMID_MAX * 256 * EDIM <= WS_O, "fp8 expert buffers fit");
constexpr int CW_TMO = 0, CW_ATQ = 1024, CW_BAR = 4096;

constexpr int RING_OFF = 0, RING_BYTES = 131072;
constexpr int LDSCTL_OFF = RING_BYTES, MISC_OFF = LDSCTL_OFF + 320;
constexpr int LDSTE_OFF = MISC_OFF + 128;
constexpr int LDS_BYTES = 147456;


struct Frame {
    LAS unsigned char* lds;
    volatile LAS unsigned* MISC;
    gu32* ctl;
    int vcu, G;
    float* out; unsigned char* ws;
};
__device__ __forceinline__ const float* inp(int k) { const __attribute__((address_space(4))) unsigned char* ka = (const __attribute__((address_space(4))) unsigned char*)__builtin_amdgcn_kernarg_segment_ptr(); asm volatile("" : "+s"(ka)); return *(const float* const __attribute__((address_space(4)))*)(ka + 8 * k); }
#define LANE_DECL int tid = threadIdx.x; asm volatile("" : "+v"(tid)); const int lane = tid & 63, wave = __builtin_amdgcn_readfirstlane(tid >> 6); (void)lane; (void)wave
__device__ __forceinline__ float wave_sum(float v) {
#pragma unroll
    for (int o = 1; o < 64; o <<= 1) v += __shfl_xor(v, o);
    return v;
}
__device__ __forceinline__ float bflo(unsigned w) { return __uint_as_float(w << 16); }
__device__ __forceinline__ float bfhi(unsigned w) { return __uint_as_float(w & 0xffff0000u); }
__device__ __forceinline__ float bf2f(bf16 h) { return __uint_as_float((unsigned)h << 16); }

template <bool VEC, class SrcFn>
__device__ __forceinline__ void p0_item(int K, int nblk, size_t ldn, bf16* WT, LAS float* scr, int item, int lane, const SrcFn& src) {
    const int kb = item / nblk, nb = item % nblk, k0 = 64 * kb, n0 = 32 * nb;
    if (VEC) {
        const float* colp = src(n0 + 4 * (lane & 7)) + (size_t)(k0 + (lane >> 3)) * ldn;
        f32x4 v[8];
#pragma unroll
        for (int i = 0; i < 8; ++i) v[i] = *(const f32x4*)(colp + (size_t)(8 * i) * ldn);
#pragma unroll
        for (int i = 0; i < 8; ++i) { LAS float* d = scr + (8 * i + (lane >> 3)) * 33 + 4 * (lane & 7); d[0] = v[i].x; d[1] = v[i].y; d[2] = v[i].z; d[3] = v[i].w; }
    } else {
        const float* colp = src(n0 + (lane & 31));
#pragma unroll 8
        for (int i = 0; i < 32; ++i) { const int kk = 2 * i + (lane >> 5); scr[kk * 33 + (lane & 31)] = colp[(size_t)(k0 + kk) * ldn]; }
    }
    LDS_WAIT(); asm volatile("" ::: "memory");
    const int c = lane & 7;
#pragma unroll
    for (int j = 0; j < 4; ++j) { const int n = (lane >> 3) + 8 * j; const LAS float* s = scr + (8 * c) * 33 + n;
        v4u o; o.x = pk2(s[0 * 33], s[1 * 33]); o.y = pk2(s[2 * 33], s[3 * 33]); o.z = pk2(s[4 * 33], s[5 * 33]); o.w = pk2(s[6 * 33], s[7 * 33]);
        *(GAS v4u*)(WT + (size_t)(n0 + n) * K + k0 + 8 * c) = o; }
    LDS_WAIT(); asm volatile("" ::: "memory");
}
template <class SrcFn>
__device__ __forceinline__ void p0_item8(int K, int nblk, size_t ldn, unsigned char* WT, LAS float* scr, int item, int lane, float scale, const SrcFn& src) {
    const int kb = item / nblk, nb = item % nblk, k0 = 64 * kb, n0 = 32 * nb;
    { const float* colp = src(n0 + 4 * (lane & 7)) + (size_t)(k0 + (lane >> 3)) * ldn;
      f32x4 v[8];
#pragma unroll
      for (int i = 0; i < 8; ++i) v[i] = *(const f32x4*)(colp + (size_t)(8 * i) * ldn);
#pragma unroll
      for (int i = 0; i < 8; ++i) { LAS float* d = scr + (8 * i + (lane >> 3)) * 33 + 4 * (lane & 7); d[0] = v[i].x * scale; d[1] = v[i].y * scale; d[2] = v[i].z * scale; d[3] = v[i].w * scale; } }
    LDS_WAIT(); asm volatile("" ::: "memory");
    const int c = lane & 3;
#pragma unroll
    for (int j = 0; j < 2; ++j) { const int n = (lane >> 2) + 16 * j; const LAS float* s = scr + (16 * c) * 33 + n;
        v4u o; o.x = pg8::pk4_fp8(s[0 * 33], s[1 * 33], s[2 * 33], s[3 * 33]); o.y = pg8::pk4_fp8(s[4 * 33], s[5 * 33], s[6 * 33], s[7 * 33]);
        o.z = pg8::pk4_fp8(s[8 * 33], s[9 * 33], s[10 * 33], s[11 * 33]); o.w = pg8::pk4_fp8(s[12 * 33], s[13 * 33], s[14 * 33], s[15 * 33]);
        *(GAS v4u*)(WT + (size_t)(n0 + n) * K + k0 + 16 * c) = o; }
    LDS_WAIT(); asm volatile("" ::: "memory");
}
__device__ __forceinline__ void p0_prologue(Frame& F) {
    LANE_DECL;
    LAS float* scr = (LAS float*)(F.lds + RING_OFF + wave * 16384);
    const int gw = F.vcu * NWAVES + wave, NGW = F.G * NWAVES;
    unsigned char* ws = F.ws;
    constexpr int I_IN = (DM / 64) * (INW / 32), I_OUT = (DM / 64) * (DM / 32), I_GU = (DM / 64) * (2 * FFD / 32), I_D = (FFD / 64) * (DM / 32);
    constexpr int I_MGU = (DM / 64) * (2 * EDIM / 32), I_MD = (EDIM / 64) * (DM / 32);
    constexpr int NITEMS = 2 * I_IN + 2 * I_OUT + I_GU + I_D + NEXP * I_MGU + NEXP * I_MD;
    for (int it = gw; it < NITEMS; it += NGW) {
        int r = it;
        if (r < 2 * I_IN) { const int l = r / I_IN; r -= l * I_IN; const float* W = inp(2) + (size_t)l * DM * INW;
            const int nb = r % (INW / 32);
            if (nb >= PC_POOL / 32 && nb < PC_RQ / 32) continue;
            if (nb >= PC_RQ / 32 && nb < PC_RV / 32)
                p0_item<false>(DM, INW / 32, INW, (bf16*)(ws + WS_WIN) + (size_t)l * INW * DM, scr, r, lane, [&](int n) -> const float* { const int p = (n - PC_RQ) & 63; return W + (n - p) + (p >> 1) + 32 * (p & 1); });
            else
                p0_item<true>(DM, INW / 32, INW, (bf16*)(ws + WS_WIN) + (size_t)l * INW * DM, scr, r, lane, [&](int n) -> const float* { return W + n; });
            continue; }
        r -= 2 * I_IN;
        if (r < 2 * I_OUT) { const int l = r / I_OUT; r -= l * I_OUT; const float* W = inp(8) + (size_t)l * DM * DM;
            p0_item<true>(DM, DM / 32, DM, (bf16*)(ws + WS_WOUT) + (size_t)l * DM * DM, scr, r, lane, [&](int n) -> const float* { return W + n; }); continue; }
        r -= 2 * I_OUT;
        if (r < I_GU) { const float* Wg = inp(13); const float* Wu = inp(14);
            p0_item<true>(DM, 2 * FFD / 32, FFD, (bf16*)(ws + WS_WGU), scr, r, lane, [&](int n) -> const float* { const int pn = n >> 8, hb = (n >> 7) & 1, j = n & 127; return (hb ? Wu : Wg) + pn * 128 + j; }); continue; }
        r -= I_GU;
        if (r < I_D) { const float* W = inp(15);
            p0_item<true>(FFD, DM / 32, DM, (bf16*)(ws + WS_WD), scr, r, lane, [&](int n) -> const float* { return W + n; }); continue; }
        r -= I_D;
        if (r < NEXP * I_MGU) { const int e = r / I_MGU; r -= e * I_MGU; const float* Wg = inp(17) + (size_t)e * DM * EDIM; const float* Wu = inp(18) + (size_t)e * DM * EDIM;
            p0_item8(DM, 2 * EDIM / 32, EDIM, (unsigned char*)(ws + WS_MGU) + (size_t)e * 2 * EDIM * DM, scr, r, lane, pg8::F8_SU, [&](int n) -> const float* { const int pn = n >> 8, hb = (n >> 7) & 1, j = n & 127; return (hb ? Wu : Wg) + pn * 128 + j; }); continue; }
        r -= NEXP * I_MGU;
        { const int e = r / I_MD; r -= e * I_MD; const float* W = inp(19) + (size_t)e * EDIM * DM;
            p0_item8(EDIM, DM / 32, DM, (unsigned char*)(ws + WS_MD) + (size_t)e * DM * EDIM, scr, r, lane, pg8::F8_SD, [&](int n) -> const float* { return W + n; }); }
    }
    const int gt = F.vcu * NTHR + tid, NT = F.G * NTHR;
    for (int o = gt; o < DEPTH * 4 * DM * 16; o += NT) {
        const int l = o >> 16, g = (o >> 14) & 3, k = (o >> 4) & (DM - 1), d4 = o & 15;
        const float* wr = inp(2) + (size_t)l * DM * INW + (size_t)k * INW + PC_POOL + g * 64;
        const float* pw = inp(5) + (size_t)l * 4 * 64 * 64 + (size_t)g * 64 * 64 + 4 * d4;
        f32x4 acc = {0.f, 0.f, 0.f, 0.f};
#pragma unroll 4
        for (int c4 = 0; c4 < 16; ++c4) { const f32x4 w4 = *(const f32x4*)(wr + 4 * c4);
            acc = acc + *(const f32x4*)(pw + (4 * c4 + 0) * 64) * w4.x + *(const f32x4*)(pw + (4 * c4 + 1) * 64) * w4.y + *(const f32x4*)(pw + (4 * c4 + 2) * 64) * w4.z + *(const f32x4*)(pw + (4 * c4 + 3) * 64) * w4.w; }
        bf16* dst = (bf16*)(ws + WS_WIN) + (size_t)l * INW * DM + (size_t)(PC_POOL + g * 64 + 4 * d4) * DM + k;
        dst[0] = (bf16)f2bf(acc.x); dst[(size_t)DM] = (bf16)f2bf(acc.y); dst[(size_t)2 * DM] = (bf16)f2bf(acc.z); dst[(size_t)3 * DM] = (bf16)f2bf(acc.w);
    }
    { const GAS f32x4* x4 = (const GAS f32x4*)inp(0); GAS v4u* xb = (GAS v4u*)(ws + WS_XB);
      for (int i = gt; i < MROWS * DM / 8; i += 4 * NT) { f32x4 a[4], b[4];
#pragma unroll
          for (int u = 0; u < 4; ++u) { a[u] = x4[2 * (i + u * NT)]; b[u] = x4[2 * (i + u * NT) + 1]; }
#pragma unroll
          for (int u = 0; u < 4; ++u) { v4u o; o.x = pk2(a[u].x, a[u].y); o.y = pk2(a[u].z, a[u].w); o.z = pk2(b[u].x, b[u].y); o.w = pk2(b[u].z, b[u].w); xb[i + u * NT] = o; } } }
}

__device__ __forceinline__ int ln_elem(int lane, int jj) { return (jj >> 1) * 512 + 8 * lane + (jj & 1) * 4; }
__device__ __forceinline__ void ln_unpack(f32x4 (&v)[4], v4u w0, v4u w1) {
    v[0] = (f32x4){bflo(w0.x), bfhi(w0.x), bflo(w0.y), bfhi(w0.y)}; v[1] = (f32x4){bflo(w0.z), bfhi(w0.z), bflo(w0.w), bfhi(w0.w)};
    v[2] = (f32x4){bflo(w1.x), bfhi(w1.x), bflo(w1.y), bfhi(w1.y)}; v[3] = (f32x4){bflo(w1.z), bfhi(w1.z), bflo(w1.w), bfhi(w1.w)};
}
__device__ __forceinline__ void ln_stats(f32x4 (&v)[4], float& mean, float& rstd) {
    float s = 0.f;
#pragma unroll
    for (int j = 0; j < 4; ++j) s += (v[j].x + v[j].y) + (v[j].z + v[j].w);
    mean = wave_sum(s) * (1.f / DM); float s2 = 0.f;
#pragma unroll
    for (int j = 0; j < 4; ++j) { v[j] = v[j] - mean; s2 += (v[j].x * v[j].x + v[j].y * v[j].y) + (v[j].z * v[j].z + v[j].w * v[j].w); }
    rstd = 1.f / sqrtf(wave_sum(s2) * (1.f / DM) + LN_EPS);
}
struct LnGains { f32x4 g[4], b[4]; };
__device__ __forceinline__ void ln_load_gains(LnGains& G, const float* g, const float* b, int lane) {
#pragma unroll
    for (int j = 0; j < 4; ++j) { G.g[j] = *(const f32x4*)(g + ln_elem(lane, j)); G.b[j] = *(const f32x4*)(b + ln_elem(lane, j)); }
}
__device__ __forceinline__ void ln_affine(f32x4 (&v)[4], float rstd, const LnGains& G) {
#pragma unroll
    for (int j = 0; j < 4; ++j) v[j] = v[j] * rstd * G.g[j] + G.b[j];
}
__device__ __forceinline__ void store_row_bf16(const f32x4 (&v)[4], bf16* orow, int lane) {
    GAS v4u* o = (GAS v4u*)orow + lane;
    v4u a, c; a.x = pk2(v[0].x, v[0].y); a.y = pk2(v[0].z, v[0].w); a.z = pk2(v[1].x, v[1].y); a.w = pk2(v[1].z, v[1].w);
    c.x = pk2(v[2].x, v[2].y); c.y = pk2(v[2].z, v[2].w); c.z = pk2(v[3].x, v[3].y); c.w = pk2(v[3].z, v[3].w);
    o[0] = a; o[64] = c;
}

template <bool ROUTER>
__device__ __forceinline__ void ln1_phase(Frame& F, int l) {
    LANE_DECL;
    const bf16* T = (const bf16*)F.out; bf16* X1 = (bf16*)(F.ws + WS_O);
    LnGains G; ln_load_gains(G, inp(9) + l * DM, inp(10) + l * DM, lane);
    LAS int* hist = (LAS int*)(F.lds + RING_OFF);
    f32x4 rw[ROUTER ? 16 : 1][2];
    if (ROUTER) { const float* rwp = inp(16);
#pragma unroll
        for (int j = 0; j < 4; ++j)
#pragma unroll
            for (int q = 0; q < 4; ++q) { const int k = ln_elem(lane, j) + q; rw[(4 * j + q) * (ROUTER ? 1 : 0)][0] = *(const f32x4*)(rwp + k * 8); rw[(4 * j + q) * (ROUTER ? 1 : 0)][1] = *(const f32x4*)(rwp + k * 8 + 4); } }
    for (int blk = F.vcu; blk < MROWS / 256; blk += F.G) {
        if (ROUTER) { if (tid < 8) hist[tid] = 0; __syncthreads(); }
        for (int i = 0; i < 32; i += 4) {
            const int row = blk * 256 + wave * 32 + i;
            v4u w0[4], w1[4];
#pragma unroll
            for (int rr = 0; rr < 4; ++rr) { const GAS v4u* tr = (const GAS v4u*)(T + (size_t)(row + rr) * DM) + lane; w0[rr] = tr[0]; w1[rr] = tr[64]; }
#pragma unroll
            for (int rr = 0; rr < 4; ++rr) {
                f32x4 v[4]; ln_unpack(v, w0[rr], w1[rr]);
                float mean, rstd; ln_stats(v, mean, rstd); ln_affine(v, rstd, G);
                store_row_bf16(v, X1 + (size_t)(row + rr) * DM, lane);
                if (ROUTER) {
                    float lg[8];
#pragma unroll
                    for (int e = 0; e < 8; ++e) lg[e] = 0.f;
#pragma unroll
                    for (int j = 0; j < 4; ++j)
#pragma unroll
                        for (int q = 0; q < 4; ++q) { const f32x4 r0 = rw[(4 * j + q) * (ROUTER ? 1 : 0)][0], r1 = rw[(4 * j + q) * (ROUTER ? 1 : 0)][1]; const float xv = v[j][q];
                            lg[0] += xv * r0.x; lg[1] += xv * r0.y; lg[2] += xv * r0.z; lg[3] += xv * r0.w; lg[4] += xv * r1.x; lg[5] += xv * r1.y; lg[6] += xv * r1.z; lg[7] += xv * r1.w; }
                    float h4[4], h2[2], h1;
                    { const bool up = (lane & 32) != 0;
#pragma unroll
                      for (int e = 0; e < 4; ++e) { const float snd = up ? lg[e] : lg[e + 4], kp = up ? lg[e + 4] : lg[e]; h4[e] = kp + __shfl_xor(snd, 32); } }
                    { const bool up = (lane & 16) != 0;
#pragma unroll
                      for (int e = 0; e < 2; ++e) { const float snd = up ? h4[e] : h4[e + 2], kp = up ? h4[e + 2] : h4[e]; h2[e] = kp + __shfl_xor(snd, 16); } }
                    { const bool up = (lane & 8) != 0; const float snd = up ? h2[0] : h2[1], kp = up ? h2[1] : h2[0]; h1 = kp + __shfl_xor(snd, 8); }
                    h1 += __shfl_xor(h1, 4); h1 += __shfl_xor(h1, 2); h1 += __shfl_xor(h1, 1);
                    float ls[8];
#pragma unroll
                    for (int e = 0; e < 8; ++e) ls[e] = __int_as_float(__builtin_amdgcn_readlane(__float_as_int(h1), ((e >> 2) & 1) * 32 + ((e >> 1) & 1) * 16 + (e & 1) * 8));
                    int e1 = 0; float v1 = ls[0];
#pragma unroll
                    for (int e = 1; e < 8; ++e) if (ls[e] > v1) { v1 = ls[e]; e1 = e; }
                    int e2 = -1; float v2 = -INFINITY;
#pragma unroll
                    for (int e = 0; e < 8; ++e) if (e != e1 && ls[e] > v2) { v2 = ls[e]; e2 = e; }
                    const float g1 = 1.f / (1.f + __expf(v2 - v1)), g2 = 1.f - g1;
                    if (lane == 0) {
                        int* re = (int*)(F.ws + WS_RE); float* rg = (float*)(F.ws + WS_RG);
                        re[2 * (row + rr)] = e1; re[2 * (row + rr) + 1] = e2; rg[2 * (row + rr)] = g1; rg[2 * (row + rr) + 1] = g2;
                        atomicAdd((int*)&hist[e1], 1); atomicAdd((int*)&hist[e2], 1);
                    }
                }
            }
        }
        if (ROUTER) { __syncthreads(); if (tid < 8) ((int*)(F.ws + WS_BC))[blk * 8 + tid] = hist[tid]; __syncthreads(); }
    }
}
__device__ __forceinline__ void ln2_phase(Frame& F, int l) {
    LANE_DECL;
    const bf16* T = (const bf16*)F.out; bf16* XB = (bf16*)(F.ws + WS_XB);
    LnGains G; ln_load_gains(G, inp(11) + l * DM, inp(12) + l * DM, lane);
    const int gw = F.vcu * NWAVES + wave, NGW = F.G * NWAVES;
    for (int r4 = gw; r4 < MROWS / 4; r4 += NGW) {
        const int row = 4 * r4;
        v4u w0[4], w1[4];
#pragma unroll
        for (int rr = 0; rr < 4; ++rr) { const GAS v4u* tr = (const GAS v4u*)(T + (size_t)(row + rr) * DM) + lane; w0[rr] = tr[0]; w1[rr] = tr[64]; }
#pragma unroll
        for (int rr = 0; rr < 4; ++rr) { f32x4 v[4]; ln_unpack(v, w0[rr], w1[rr]);
            float mean, rstd; ln_stats(v, mean, rstd); ln_affine(v, rstd, G);
            store_row_bf16(v, XB + (size_t)(row + rr) * DM, lane); }
    }
}

__device__ __forceinline__ void route_phase(Frame& F) {
    LANE_DECL;
    LAS int* cnts = (LAS int*)(F.lds + RING_OFF);
    LAS int* tot = cnts + 2048; LAS int* offp = tot + 8; LAS int* base = offp + 8; LAS int* wcnt = base + 8; LAS int* ntl = wcnt + 64;
    const int* bc = (const int*)(F.ws + WS_BC); const int* re = (const int*)(F.ws + WS_RE);
    int* rs = (int*)(F.ws + WS_RS); int* mi = (int*)(F.ws + WS_MI);
    const bf16* X1 = (const bf16*)(F.ws + WS_O); unsigned char* XG8 = F.ws + WS_XG8;
    for (int blk = F.vcu; blk < MROWS / 256; blk += F.G) {
        __syncthreads();
        for (int i = tid; i < 2048; i += NTHR) cnts[i] = bc[i];
        __syncthreads();
        if (tid < 8) { int run = 0, mine = 0; for (int w = 0; w < 256; ++w) { if (w == blk) mine = run; run += cnts[w * 8 + tid]; } tot[tid] = run; base[tid] = mine; }
        __syncthreads();
        if (tid == 0) { int off = 0; for (int e = 0; e < 8; ++e) { offp[e] = off; off += (tot[e] + 255) & ~255; } ntl[0] = off >> 8; }
        __syncthreads();
        const int a = tid, tok = blk * 256 + (a >> 1), k = a & 1;
        const int e = re[2 * tok + k];
        int rk = 0;
#pragma unroll
        for (int ee = 0; ee < 8; ++ee) { const unsigned long long mask = __ballot(e == ee); if (e == ee) rk = __popcll(mask & ((1ull << lane) - 1ull)); if (lane == 0) wcnt[wave * 8 + ee] = __popcll(mask); }
        __syncthreads();
        int wb = 0;
        for (int w = 0; w < wave; ++w) wb += wcnt[w * 8 + e];
        const int slot = offp[e] + base[e] + wb + rk;
        rs[2 * tok + k] = slot;
        for (int i = 0; i < 64; i += 4) { const int s0 = __shfl(slot, i), s1 = __shfl(slot, i + 1), s2 = __shfl(slot, i + 2), s3 = __shfl(slot, i + 3), ta = __shfl(tok, i), tb = __shfl(tok, i + 2);
            const GAS v4u* srca = (const GAS v4u*)(X1 + (size_t)ta * DM) + 2 * lane; const GAS v4u* srcb = (const GAS v4u*)(X1 + (size_t)tb * DM) + 2 * lane;
            const v4u a0 = srca[0], a1 = srca[1], b0 = srcb[0], b1 = srcb[1];
            v4u oa, ob; const float sx = pg8::F8_SX;
            oa.x = pg8::pk4_fp8(sx * bflo(a0.x), sx * bfhi(a0.x), sx * bflo(a0.y), sx * bfhi(a0.y)); oa.y = pg8::pk4_fp8(sx * bflo(a0.z), sx * bfhi(a0.z), sx * bflo(a0.w), sx * bfhi(a0.w));
            oa.z = pg8::pk4_fp8(sx * bflo(a1.x), sx * bfhi(a1.x), sx * bflo(a1.y), sx * bfhi(a1.y)); oa.w = pg8::pk4_fp8(sx * bflo(a1.z), sx * bfhi(a1.z), sx * bflo(a1.w), sx * bfhi(a1.w));
            ob.x = pg8::pk4_fp8(sx * bflo(b0.x), sx * bfhi(b0.x), sx * bflo(b0.y), sx * bfhi(b0.y)); ob.y = pg8::pk4_fp8(sx * bflo(b0.z), sx * bfhi(b0.z), sx * bflo(b0.w), sx * bfhi(b0.w));
            ob.z = pg8::pk4_fp8(sx * bflo(b1.x), sx * bfhi(b1.x), sx * bflo(b1.y), sx * bfhi(b1.y)); ob.w = pg8::pk4_fp8(sx * bflo(b1.z), sx * bfhi(b1.z), sx * bflo(b1.w), sx * bfhi(b1.w));
            *((GAS v4u*)(XG8 + (size_t)s0 * DM) + lane) = oa; *((GAS v4u*)(XG8 + (size_t)s1 * DM) + lane) = oa; *((GAS v4u*)(XG8 + (size_t)s2 * DM) + lane) = ob; *((GAS v4u*)(XG8 + (size_t)s3 * DM) + lane) = ob; }
        for (int ee = 0; ee < 8; ++ee) { const int lo = offp[ee] + tot[ee], hi = offp[ee] + ((tot[ee] + 255) & ~255);
            for (int s = lo + blk; s < hi; s += MROWS / 256) { if (tid < 256) ((GAS unsigned*)(XG8 + (size_t)s * DM))[tid] = 0u; } }
        if (blk == 0) { const int ntiles = ntl[0];
            if (tid == 0) mi[0] = ntiles;
            for (int t = tid; t < ntiles; t += NTHR) { int ee = 0;
#pragma unroll
                for (int x = 1; x < 8; ++x) if (t * 256 >= offp[x]) ee = x;
                mi[16 + t] = ee; } }
    }
}

__device__ __forceinline__ void f8_unpack(f32x4 (&v)[4], unsigned long long w0, unsigned long long w1, float s) {
    typedef float f2_ __attribute__((ext_vector_type(2)));
    const int a = (int)(unsigned)w0, b = (int)(unsigned)(w0 >> 32), c = (int)(unsigned)w1, d = (int)(unsigned)(w1 >> 32);
    const f2_ a0 = __builtin_amdgcn_cvt_pk_f32_fp8(a, false), a1 = __builtin_amdgcn_cvt_pk_f32_fp8(a, true), b0 = __builtin_amdgcn_cvt_pk_f32_fp8(b, false), b1 = __builtin_amdgcn_cvt_pk_f32_fp8(b, true);
    const f2_ c0 = __builtin_amdgcn_cvt_pk_f32_fp8(c, false), c1 = __builtin_amdgcn_cvt_pk_f32_fp8(c, true), d0 = __builtin_amdgcn_cvt_pk_f32_fp8(d, false), d1 = __builtin_amdgcn_cvt_pk_f32_fp8(d, true);
    v[0] = (f32x4){a0.x, a0.y, a1.x, a1.y} * s; v[1] = (f32x4){b0.x, b0.y, b1.x, b1.y} * s; v[2] = (f32x4){c0.x, c0.y, c1.x, c1.y} * s; v[3] = (f32x4){d0.x, d0.y, d1.x, d1.y} * s;
}
__device__ __forceinline__ void moe_out_phase(Frame& F, int l) {
    LANE_DECL;
    const bf16* X1 = (const bf16*)(F.ws + WS_O); const unsigned char* YB = F.ws + WS_XG;
    const int* rs = (const int*)(F.ws + WS_RS); const float* rg = (const float*)(F.ws + WS_RG);
    LnGains G; ln_load_gains(G, inp(11) + l * DM, inp(12) + l * DM, lane);
    const int gw = F.vcu * NWAVES + wave, NGW = F.G * NWAVES;
    constexpr float IY = 1.0f / pg8::F8_SY;
    for (int rp = gw; rp < MROWS / 4; rp += NGW) {
        const int row = 4 * rp;
        const v4u sa = *(const v4u*)(rs + 2 * row), sb = *(const v4u*)(rs + 2 * row + 4); const f32x4 ga = *(const f32x4*)(rg + 2 * row), gb = *(const f32x4*)(rg + 2 * row + 4);
        const int s1[4] = {(int)sa.x, (int)sa.z, (int)sb.x, (int)sb.z}, s2[4] = {(int)sa.y, (int)sa.w, (int)sb.y, (int)sb.w}; const float g1[4] = {ga.x * IY, ga.z * IY, gb.x * IY, gb.z * IY}, g2[4] = {ga.y * IY, ga.w * IY, gb.y * IY, gb.w * IY};
        v4u xa[4][2]; unsigned long long pa[4][2], qa[4][2];
#pragma unroll
        for (int rr = 0; rr < 4; ++rr) {
            const GAS v4u* xr = (const GAS v4u*)(X1 + (size_t)(row + rr) * DM) + lane;
            const GAS unsigned long long* y1 = (const GAS unsigned long long*)(YB + (size_t)s1[rr] * DM) + lane;
            const GAS unsigned long long* y2 = (const GAS unsigned long long*)(YB + (size_t)s2[rr] * DM) + lane;
            xa[rr][0] = xr[0]; xa[rr][1] = xr[64]; pa[rr][0] = y1[0]; pa[rr][1] = y1[64]; qa[rr][0] = y2[0]; qa[rr][1] = y2[64]; }
#pragma unroll
        for (int rr = 0; rr < 4; ++rr) {
            f32x4 v[4], p[4], q[4]; ln_unpack(v, xa[rr][0], xa[rr][1]); f8_unpack(p, pa[rr][0], pa[rr][1], g1[rr]); f8_unpack(q, qa[rr][0], qa[rr][1], g2[rr]);
#pragma unroll
            for (int j = 0; j < 4; ++j) v[j] = v[j] * ALPHA + (p[j] + q[j]);
            float mean, rstd; ln_stats(v, mean, rstd); ln_affine(v, rstd, G);
            GAS f32x4* o = (GAS f32x4*)(F.out + (size_t)(row + rr) * DM) + 2 * lane;
            o[0] = v[0]; o[1] = v[1]; o[128] = v[2]; o[129] = v[3];
        }
    }
}

__device__ __forceinline__ float lam_init_of(int l) { return l == 0 ? 0.2f : 0.35550906759096934f; }
__device__ __forceinline__ float lambda_of(int l, int lane) {
    const float* dl = inp(3) + l * 256; const int ln = lane;
    const float a = wave_sum(dl[ln] * dl[64 + ln]), b = wave_sum(dl[128 + ln] * dl[192 + ln]);
    return __expf(a) - __expf(b) + lam_init_of(l);
}
__device__ __forceinline__ void combine_phase(Frame& F, int l) {
    LANE_DECL;
    const bf16* P = (const bf16*)(F.ws + WS_P); bf16* Y = (bf16*)(F.ws + WS_Y);
    const float* psc = inp(6) + l * 256;
    const f32x4 ps = *(const f32x4*)(psc + 4 * lane);
    const int grp = lane >> 4, win = 2 << grp;
    const int gw = F.vcu * NWAVES + wave, NGW = F.G * NWAVES;
    for (int rb = gw; rb < MROWS / 32; rb += NGW) {
        const int row0 = rb * 32, t0 = row0 & (SEQ - 1);
        f32x4 acc = {0.f, 0.f, 0.f, 0.f};
        for (int j = 1; j <= 16; ++j) { if (j <= win && t0 - j >= 0) { const unsigned long long w = *((const GAS unsigned long long*)(P + (size_t)(row0 - j) * INW + PC_POOL) + lane);
                acc = acc + (f32x4){bflo((unsigned)w), bfhi((unsigned)w), bflo((unsigned)(w >> 32)), bfhi((unsigned)(w >> 32))}; } }
        for (int i0 = 0; i0 < 32; i0 += 8) {
            unsigned long long pc[8], po[8];
#pragma unroll
            for (int u = 0; u < 8; ++u) { const int row = row0 + i0 + u, t = t0 + i0 + u;
                pc[u] = *((const GAS unsigned long long*)(P + (size_t)row * INW + PC_POOL) + lane);
                const int ro = (t - win >= 0) ? row - win : row;
                po[u] = *((const GAS unsigned long long*)(P + (size_t)ro * INW + PC_POOL) + lane); }
#pragma unroll
            for (int u = 0; u < 8; ++u) { const int row = row0 + i0 + u, t = t0 + i0 + u;
                const f32x4 cur = {bflo((unsigned)pc[u]), bfhi((unsigned)pc[u]), bflo((unsigned)(pc[u] >> 32)), bfhi((unsigned)(pc[u] >> 32))};
                const f32x4 old = {bflo((unsigned)po[u]), bfhi((unsigned)po[u]), bflo((unsigned)(po[u] >> 32)), bfhi((unsigned)(po[u] >> 32))};
                acc = acc + cur; if (t - win >= 0) acc = acc - old;
                const int cnt = (t + 1 < win) ? t + 1 : win; const float ic = 1.0f / (float)cnt;
                const f32x4 po4 = (acc * ic - cur) * ps;
                *((GAS unsigned long long*)(Y + (size_t)row * DM + 512) + lane) = (unsigned long long)pk2(po4.x, po4.y) | ((unsigned long long)pk2(po4.z, po4.w) << 32);
            }
        }
    }
}

__device__ __forceinline__ int t5_bucket(int n) {
    if (n < 16) return n;
    const float v = (__log2f((float)n) - 4.0f) * (16.0f / 3.0f);
    const int b = 16 + (int)v; return b < 31 ? b : 31;
}
struct AttnAux {
    static constexpr long O0_OFF = ((long)WS_O - (long)WS_Y) / 2;
    static __device__ __forceinline__ float lam(int l, int lane) { return __int_as_float(__builtin_amdgcn_readfirstlane(__float_as_int(lambda_of(l, lane)))); }
    static __device__ __forceinline__ float post(int l) { return 1.0f - lam_init_of(l); }
    static __device__ __forceinline__ const float* sg(int l) { return inp(4) + l * 128; }
};
__device__ __forceinline__ void mixers_phase(Frame& F, int l, char* lds_generic) {
    ret::ret_kv_units(F.lds + RING_OFF, (const unsigned short*)(F.ws + WS_P), (float*)(F.ws + WS_AT), F.vcu, F.G, BATCH * 4 * (SEQ / 128));
    __syncthreads();
    attn_body::attn_phase_w<8, AttnAux>(lds_generic + RING_OFF, (const attn_body::bf16*)(F.ws + WS_P), (attn_body::bf16*)(F.ws + WS_O), (attn_body::bf16*)(F.ws + WS_Y), inp(1), F.vcu, l, (unsigned*)(F.ctl + CW_ATQ) + l * 8 * 32, F.MISC + 20);
}
__device__ __forceinline__ void ret_out_phase(Frame& F, int l) {
    for (int u = F.vcu; u < BATCH * 4 * 8; u += F.G) ret::ret_out_unit(F.lds + RING_OFF, (const unsigned short*)(F.ws + WS_P), (unsigned short*)(F.ws + WS_Y), (const float*)(F.ws + WS_AT), inp(7) + l * 256, u);
}

#ifndef MK_ONE_LAUNCH
#define MK_ONE_LAUNCH 1
#endif
constexpr int N_PHASES = 26;
__device__ __forceinline__ int cta_id() { int c = blockIdx.x; asm volatile("" : "+s"(c)); return c; }
struct Args { const float* in[20]; float* out; unsigned char* ws; int ph_lo, ph_hi; };
__global__ void __launch_bounds__(NTHR, 2) hymba_fwd(Args args) {
    extern __shared__ __attribute__((aligned(16))) unsigned char lds[];
    Frame F;
    F.lds = (LAS unsigned char*)lds;
    F.MISC = (volatile LAS unsigned*)(F.lds + MISC_OFF);
    F.G = gridDim.x; { const int bx = blockIdx.x; F.vcu = (F.G % 8 == 0) ? (bx % 8) * (F.G / 8) + bx / 8 : bx; }
    F.ws = args.ws; F.out = args.out; F.ctl = (gu32*)(args.ws + WS_CTL);
    for (int u = threadIdx.x; u < (LDS_BYTES - LDSCTL_OFF) / 4; u += NTHR) ((LAS unsigned*)(F.lds + LDSCTL_OFF))[u] = 0u;
    __syncthreads();
#if MK_ONE_LAUNCH
    XcdBarrier bar = xcd_barrier_post((unsigned*)(F.ctl + CW_BAR), F.MISC + 8);
#define GRID_BAR() xcd_barrier(bar)
#else
#define GRID_BAR() do {} while (0)
#endif
    const int lo = args.ph_lo, hi = args.ph_hi;
#ifndef PHASE_OK
#define PHASE_OK(k) true
#endif
#define IN(k) (PHASE_OK(k) && lo <= (k) && (k) < hi)
#define SEAM(k) do { if (IN((k) + 1)) GRID_BAR(); } while (0)
#ifndef REPEAT_OK
#define REPEAT_OK(k) false
#endif
#define RUN(k, ...) do { if (IN(k)) { __VA_ARGS__ if (REPEAT_OK(k)) { GRID_BAR(); __VA_ARGS__ } SEAM(k); } } while (0)
    unsigned char* ws = args.ws;
    bf16* XB = (bf16*)(ws + WS_XB); bf16* Y = (bf16*)(ws + WS_Y); bf16* P = (bf16*)(ws + WS_P); bf16* X1 = (bf16*)(ws + WS_O);

    RUN(0, p0_prologue(F););

    for (int l = 0; l < DEPTH; ++l) {
        const int pb = 1 + 8 * l;
        RUN(pb + 0,
            pg8::Gemm g{XB, (const bf16*)(ws + WS_WIN) + (size_t)l * INW * DM, MROWS, INW, DM, 0};
            pg8::GOrder S; S.init(MROWS / 256, INW, F.G, cta_id(), 0, 0, nullptr);
            pg8::EpiInProj E{P};
            pg8::gemm_phase<pg8::EpiInProj, pg8::GOrder, true, true>(F.lds + RING_OFF, g, S, E);
            );
        RUN(pb + 1, mixers_phase(F, l, (char*)lds););
        RUN(pb + 2, ret_out_phase(F, l); combine_phase(F, l););
        RUN(pb + 3,
            pg8::Gemm g{Y, (const bf16*)(ws + WS_WOUT) + (size_t)l * DM * DM, MROWS, DM, DM, 0};
            pg8::GOrder S; S.init(MROWS / 256, DM, F.G, cta_id(), 0, 0, nullptr);
            pg8::EpiResid E{XB, (bf16*)F.out, ALPHA};
            pg8::gemm_phase<pg8::EpiResid, pg8::GOrder, true, true>(F.lds + RING_OFF, g, S, E);
            );
        if (l == 0) {
            RUN(5, ln1_phase<false>(F, l););
            RUN(6,
                pg8::Gemm g{X1, (const bf16*)(ws + WS_WGU), MROWS, 2 * FFD, DM, 0};
                pg8::GOrder S; S.init(MROWS / 256, 2 * FFD, F.G, cta_id(), 0, 0, nullptr);
                pg8::EpiSwiGLU E{P, FFD};
                pg8::gemm_phase<pg8::EpiSwiGLU, pg8::GOrder, true, true>(F.lds + RING_OFF, g, S, E);
                );
            RUN(7,
                pg8::Gemm g{P, (const bf16*)(ws + WS_WD), MROWS, DM, FFD, 0};
                pg8::GOrder S; S.init(MROWS / 256, DM, F.G, cta_id(), 0, 0, nullptr);
                pg8::EpiResid E{X1, (bf16*)F.out, ALPHA};
                pg8::gemm_phase<pg8::EpiResid, pg8::GOrder, true, true>(F.lds + RING_OFF, g, S, E);
                );
            RUN(8, ln2_phase(F, l););
        } else {
            RUN(13, ln1_phase<true>(F, l););
            RUN(14, route_phase(F););
            if (IN(15) || IN(16) || IN(17) || IN(18)) {
                const int* mi = (const int*)(ws + WS_MI);
                const int ntiles = (int)__builtin_amdgcn_readfirstlane((int)__hip_atomic_load(mi, __ATOMIC_RELAXED, __HIP_MEMORY_SCOPE_AGENT));
                LAS int* lds_te = (LAS int*)(F.lds + LDSTE_OFF);
                __syncthreads(); { int ti_ = threadIdx.x; asm volatile("" : "+v"(ti_)); for (int i = ti_; i < ntiles; i += NTHR) lds_te[i] = (int)__hip_atomic_load(mi + 16 + i, __ATOMIC_RELAXED, __HIP_MEMORY_SCOPE_AGENT); } __syncthreads();
                for (int s = 0; s < 4; ++s) {
                    if (!IN(15 + s)) continue;
                    const int tmid = ntiles - QLAST > QTILES ? ntiles - QLAST : QTILES;
                    int xd = 0;
                    if (s >= 1) {
                        const int t0 = s == 1 ? 0 : s == 2 ? QTILES : tmid, t1 = s == 1 ? QTILES : s == 2 ? tmid : ntiles;
                        pg8::Gemm g{(const bf16*)(ws + ((s & 1) ? WS_HQ8 : WS_HQ8B)), (const bf16*)(ws + WS_MD), (t1 - t0) * 256, DM, EDIM, (size_t)EDIM * DM};
                        pg8::GOrder S; S.init(t1 - t0, DM, F.G, cta_id(), 0, t0, lds_te + t0);
                        pg8::EpiPlain8 E{ws + WS_XG, DM, pg8::F8_SY / (pg8::F8_SH * pg8::F8_SD)};
                        pg8::gemm_phase<pg8::EpiPlain8, pg8::GOrder, true, true, true>(F.lds + RING_OFF, g, S, E);
                        xd = ((t1 - t0) * (DM / 256)) % F.G;
                    }
                    if (s <= 2) {
                        const int t0 = s == 0 ? 0 : s == 1 ? QTILES : tmid, t1 = s == 0 ? QTILES : s == 1 ? tmid : ntiles;
                        pg8::Gemm g{(const bf16*)(ws + WS_XG8), (const bf16*)(ws + WS_MGU), (t1 - t0) * 256, 2 * EDIM, DM, (size_t)2 * EDIM * DM};
                        pg8::GOrder S; S.init(t1 - t0, 2 * EDIM, F.G, cta_id(), t0, 0, lds_te + t0);
                        const int nup = (t1 - t0) * (2 * EDIM / 256);
                        if (xd > 0 && xd <= 64 && F.G == 256 && nup % F.G == 0 && nup / F.G >= 3) S.donate(xd);
                        pg8::EpiSwiGLU8 E{ws + ((s & 1) ? WS_HQ8B : WS_HQ8), EDIM};
                        pg8::gemm_phase<pg8::EpiSwiGLU8, pg8::GOrder, true, true, true>(F.lds + RING_OFF, g, S, E);
                    }
                    SEAM(15 + s);
                }
            }
            RUN(25, moe_out_phase(F, l););
        }
    }
#ifdef PROBE_BARWAIT
    {
        gu32* acc = F.ctl + 3968;
        if (threadIdx.x == 0) { const unsigned w = F.MISC[8 + 8]; __hip_atomic_fetch_add(acc, w, __ATOMIC_RELAXED, __HIP_MEMORY_SCOPE_AGENT); }
        GRID_BAR();
        if (blockIdx.x == 0 && threadIdx.x == 0) { unsigned tot = __hip_atomic_load(acc, __ATOMIC_RELAXED, __HIP_MEMORY_SCOPE_AGENT); tot = tot / gridDim.x * PROBE_AMP;
            const unsigned long long t0 = __builtin_amdgcn_s_memrealtime(); while (__builtin_amdgcn_s_memrealtime() - t0 < (unsigned long long)tot) __builtin_amdgcn_s_sleep(8); }
    }
#endif
#undef IN
#undef SEAM
}

extern "C" void kernel_launch(void* const* d_in, const int* in_sizes, int n_in, void* d_out, int out_size, void* d_ws, size_t ws_size, hipStream_t stream) {
    static int grid = 0;
    if (grid == 0) {
        if (n_in != 20 || in_sizes[0] != MROWS * DM || out_size != MROWS * DM || ws_size < WS_END) { fprintf(stderr, "kernel_launch: unexpected shapes (n_in %d, ws %zu); nothing launched\n", n_in, ws_size); grid = -1; return; }
        int dev = 0, cus = 0, per_cu = 0;
        if (hipGetDevice(&dev) != hipSuccess || hipDeviceGetAttribute(&cus, hipDeviceAttributeMultiprocessorCount, dev) != hipSuccess) { grid = -1; return; }
        if (hipFuncSetAttribute((const void*)hymba_fwd, hipFuncAttributeMaxDynamicSharedMemorySize, LDS_BYTES) != hipSuccess) { grid = -1; return; }
        if (hipOccupancyMaxActiveBlocksPerMultiprocessor(&per_cu, (const void*)hymba_fwd, NTHR, LDS_BYTES) != hipSuccess || per_cu < 1) { fprintf(stderr, "kernel_launch: occupancy query reports %d\n", per_cu); }
        (void)hipGetLastError();
        grid = cus;
    }
    if (grid < 0) return;
    if (hipMemsetAsync((char*)d_ws + WS_CTL, 0, CTL_ZERO_BYTES, stream) != hipSuccess) return;
    Args a{};
    for (int i = 0; i < 20; ++i) a.in[i] = (const float*)d_in[i];
    a.out = (float*)d_out; a.ws = (unsigned char*)d_ws;
#if MK_ONE_LAUNCH
    a.ph_lo = 0; a.ph_hi = N_PHASES;
    hipLaunchKernelGGL(hymba_fwd, dim3(grid), dim3(NTHR), LDS_BYTES, stream, a);
#else
    for (int p = 0; p < N_PHASES; ++p) { a.ph_lo = p; a.ph_hi = p + 1; hipLaunchKernelGGL(hymba_fwd, dim3(grid), dim3(NTHR), LDS_BYTES, stream, a); }
#endif
}
```

```cpp
#include <hip/hip_runtime.h>
#include <cstdio>
#include <cstdint>
#include <cmath>
#include <hip/hip_bf16.h>
#define MK_ONE_LAUNCH 1
namespace pg8 {
#define PG8_LAS __attribute__((address_space(3)))
typedef unsigned short bf16_t;
typedef short bf16x8 __attribute__((ext_vector_type(8)));
typedef float f32x4 __attribute__((ext_vector_type(4)));
typedef unsigned u32x4 __attribute__((ext_vector_type(4)));
constexpr int BM = 256, BK = 64, HALF = 128, HTB = HALF * BK * 2  , STAGE_BYTES = 8 * HTB, NXCD = 8, WGM = 8;

__host__ __device__ __forceinline__ int lds_byte(int r, int c) { const int st = (r >> 4) * 2 + (c >> 5), rr = r & 15, cc = c & 31, ob = rr * 64 + cc * 2; return st * 1024 + (ob ^ (((ob >> 9) & 1) << 5)); }
__host__ __device__ __forceinline__ void stage_rc(int b, int& R, int& C) { const int st = b / 1024, sb = b % 1024, swz = sb ^ (((sb >> 9) & 1) << 5); R = (st >> 1) * 16 + swz / 64; C = (st & 1) * 32 + (swz % 64) / 2; }
__host__ __device__ __forceinline__ int perm32(int rho) { const int n = rho >> 4, i = rho & 15; return 8 * (i >> 2) + 4 * n + (i & 3); }

struct Unit { int pm, pn, am, e; };
struct Gemm { const bf16_t* A; const bf16_t* Bt; int M, N, K; size_t bstride; };

struct StaticOrder {
    int nM, nN, nwg, G, c;
    __host__ __device__ void init(int M, int N, int G_, int c_) { nM = M / BM; nN = N / BM; nwg = nM * nN; G = G_; c = c_; }
    __host__ __device__ bool next(int i, Unit& u) const { return unit_of((long)i * G + c, u); }
    __host__ __device__ bool unit_of(long L, Unit& u) const {
        if (L >= nwg) return false;
        int wgid = (int)L; { const int q = nwg / NXCD, r = nwg % NXCD, xcd = wgid % NXCD, off = wgid / NXCD; wgid = (xcd < r ? xcd * (q + 1) : r * (q + 1) + (xcd - r) * q) + off; }
        const int nig = WGM * nN, gid = wgid / nig, fm = gid * WGM, gsz = (nM - fm) < WGM ? (nM - fm) : WGM;
        u.pm = fm + ((wgid % nig) % gsz); u.pn = (wgid % nig) / gsz; u.am = u.pm; u.e = 0; return true;
    }
    __device__ __forceinline__ void a_ready(const Unit&) const {}
    __device__ __forceinline__ void done(const Unit&) const {}
};

__device__ __forceinline__ unsigned cvt_pk_bf16(float lo, float hi) { unsigned r; asm volatile("v_cvt_pk_bf16_f32 %0, %1, %2" : "=v"(r) : "v"(lo), "v"(hi)); return r; }
typedef float f32x2 __attribute__((ext_vector_type(2)));
typedef unsigned u32x2 __attribute__((ext_vector_type(2)));
__device__ __forceinline__ float bf_lo(unsigned w) { return __uint_as_float(w << 16); }
__device__ __forceinline__ float bf_hi(unsigned w) { return __uint_as_float(w & 0xffff0000u); }
__device__ __forceinline__ float silu_f(float x) { return x * __builtin_amdgcn_rcpf(1.0f + __builtin_amdgcn_exp2f(-1.4426950408889634f * x)); }
__device__ __forceinline__ float lg2_gamma(int h) { return h == 0 ? -0.04580368961312479f : h == 1 ? -0.02272007650008353f : h == 2 ? -0.011315313227834146f : -0.005646563141142063f; }
typedef float f32x2e __attribute__((ext_vector_type(2)));
__device__ __forceinline__ f32x2e swiglu_pk(f32x2e g, f32x2e u) {
    const f32x2e t = g * (-1.4426950408889634f); f32x2e ex; ex.x = __builtin_amdgcn_exp2f(t.x); ex.y = __builtin_amdgcn_exp2f(t.y);
    const f32x2e d = ex + 1.0f; f32x2e s; s.x = __builtin_amdgcn_rcpf(d.x); s.y = __builtin_amdgcn_rcpf(d.y);
    return (g * u) * s; }
constexpr float QSCALE = 0.18033688011112042f;

struct GOrder {
    StaticOrder so; int a_off, o_off; const PG8_LAS int* tile_e; int xd, sd;
    __device__ __forceinline__ void init(int ntiles, int N, int G, int c, int a_off_, int o_off_, const PG8_LAS int* te) { so.init(ntiles * BM, N, G, c); a_off = a_off_; o_off = o_off_; tile_e = te; xd = 0; sd = 8; }
    __device__ __forceinline__ void donate(int xd_) { xd = xd_; sd = (xd_ + 7) & ~7; }
    __device__ __forceinline__ bool next(int i, Unit& u) const {
        long L = (long)i * so.G + so.c;
        if (xd > 0) { const int R = so.nwg / so.G;
            if (so.c < xd) { if (i >= R - 3) return false; }
            else if (i >= R) { const int k = so.c / sd - 1, cd = so.c - (k + 1) * sd; if (i > R || k < 0 || k > 2 || cd >= xd) return false; L = (long)(R - 3 + k) * so.G + cd; } }
        if (!so.unit_of(L, u)) return false;
        const int loc = u.pm; u.am = loc + a_off; u.pm = loc + o_off;
        u.e = tile_e ? (int)__builtin_amdgcn_readfirstlane(tile_e[loc]) : 0; return true;
    }
    __device__ __forceinline__ void a_ready(const Unit&) const {}
    __device__ __forceinline__ void done(const Unit&) const {}
};

struct EpiInProj {
    static constexpr bool PERM = true, AFTER_DRAIN = false;
    bf16_t* O;
    __device__ __forceinline__ void operator()(const f32x4 (&acc)[2][2][4][2], const Unit& u, int wr, int wc, int fr, int fq) const {
        constexpr int LDC = 2816;
        const int row0 = u.pm * BM + wr * 64 + fr, col0 = u.pn * BM + wc * 32 + 8 * fq, pn = u.pn;
        const int kind = (pn < 2) ? 1 : (pn == 7) ? 2 : (pn == 8) ? 3 : (pn == 10) ? 4 : 0;
        if (kind == 2 || kind == 3) {
            const int i0 = (wc & 1) * 16 + 4 * fq;
            float inv4[4];
#pragma unroll
            for (int jj = 0; jj < 4; ++jj) inv4[jj] = __builtin_amdgcn_exp2f(-(float)(i0 + jj) * 0.42863588321127255f);
            const float lg0 = lg2_gamma(wc >> 1), lg1 = lg2_gamma(2 + (wc >> 1));
#pragma unroll
            for (int ai = 0; ai < 2; ++ai)
#pragma unroll
                for (int m = 0; m < 4; ++m) {
                    const int row = row0 + ai * HALF + m * 16, pos = row & 8191; const float fi = (float)(pos & 127);
                    bf16_t* rowp = O + (size_t)row * LDC + col0;
                    float cs[4], sn[4];
#pragma unroll
                    for (int jj = 0; jj < 4; ++jj) { const float ang = (float)pos * inv4[jj]; float rv = ang * 0.15915494309189535f; rv = rv - __builtin_floorf(rv); cs[jj] = __builtin_amdgcn_cosf(rv); sn[jj] = __builtin_amdgcn_sinf(rv); }
#pragma unroll
                    for (int bj = 0; bj < 2; ++bj) {
                        const float lg = bj ? lg1 : lg0;
                        const float f = (kind == 2) ? __builtin_amdgcn_exp2f(fi * lg) : 0.125f * __builtin_amdgcn_exp2f(-fi * lg);
                        const f32x4 v0 = acc[ai][bj][m][0], v1 = acc[ai][bj][m][1];
                        const float a0 = (v0[0] * cs[0] - v0[1] * sn[0]) * f, b0 = (v0[0] * sn[0] + v0[1] * cs[0]) * f;
                        const float a1 = (v0[2] * cs[1] - v0[3] * sn[1]) * f, b1 = (v0[2] * sn[1] + v0[3] * cs[1]) * f;
                        const float a2 = (v1[0] * cs[2] - v1[1] * sn[2]) * f, b2 = (v1[0] * sn[2] + v1[1] * cs[2]) * f;
                        const float a3 = (v1[2] * cs[3] - v1[3] * sn[3]) * f, b3 = (v1[2] * sn[3] + v1[3] * cs[3]) * f;
                        u32x4 w; w.x = cvt_pk_bf16(a0, b0); w.y = cvt_pk_bf16(a1, b1); w.z = cvt_pk_bf16(a2, b2); w.w = cvt_pk_bf16(a3, b3);
                        *(u32x4*)(rowp + bj * HALF) = w; }
                }
        } else {
            const float sc = (kind == 1) ? QSCALE : 1.0f;
#pragma unroll
            for (int ai = 0; ai < 2; ++ai)
#pragma unroll
                for (int m = 0; m < 4; ++m) { bf16_t* rowp = O + (size_t)(row0 + ai * HALF + m * 16) * LDC + col0;
#pragma unroll
                    for (int bj = 0; bj < 2; ++bj) { f32x4 v0 = acc[ai][bj][m][0] * sc, v1 = acc[ai][bj][m][1] * sc;
                        if (kind == 4) { v0 = (f32x4){silu_f(v0[0]), silu_f(v0[1]), silu_f(v0[2]), silu_f(v0[3])}; v1 = (f32x4){silu_f(v1[0]), silu_f(v1[1]), silu_f(v1[2]), silu_f(v1[3])}; }
                        u32x4 w; w.x = cvt_pk_bf16(v0[0], v0[1]); w.y = cvt_pk_bf16(v0[2], v0[3]); w.z = cvt_pk_bf16(v1[0], v1[1]); w.w = cvt_pk_bf16(v1[2], v1[3]);
                        *(u32x4*)(rowp + bj * HALF) = w; } }
        }
    }
};
struct EpiResid {
    static constexpr bool PERM = true, AFTER_DRAIN = false;
    const bf16_t* X; bf16_t* T; float alpha;
    __device__ __forceinline__ void operator()(const f32x4 (&acc)[2][2][4][2], const Unit& u, int wr, int wc, int fr, int fq) const {
        const int row0 = u.pm * BM + wr * 64 + fr, col0 = u.pn * BM + wc * 32 + 8 * fq;
#pragma unroll
        for (int ai = 0; ai < 2; ++ai)
#pragma unroll
            for (int m = 0; m < 4; ++m) { const size_t off = (size_t)(row0 + ai * HALF + m * 16) * 1024 + col0;
#pragma unroll
                for (int bj = 0; bj < 2; ++bj) { const u32x4 xr = *(const u32x4*)(X + off + bj * HALF); const f32x4 v0 = acc[ai][bj][m][0], v1 = acc[ai][bj][m][1];
                    u32x4 w; w.x = cvt_pk_bf16(alpha * bf_lo(xr.x) + v0[0], alpha * bf_hi(xr.x) + v0[1]); w.y = cvt_pk_bf16(alpha * bf_lo(xr.y) + v0[2], alpha * bf_hi(xr.y) + v0[3]);
                    w.z = cvt_pk_bf16(alpha * bf_lo(xr.z) + v1[0], alpha * bf_hi(xr.z) + v1[1]); w.w = cvt_pk_bf16(alpha * bf_lo(xr.w) + v1[2], alpha * bf_hi(xr.w) + v1[3]);
                    *(u32x4*)(T + off + bj * HALF) = w; } }
    }
};
struct EpiSwiGLU {
    static constexpr bool PERM = true, AFTER_DRAIN = false;
    bf16_t* H; int ldc;
    __device__ __forceinline__ void operator()(const f32x4 (&acc)[2][2][4][2], const Unit& u, int wr, int wc, int fr, int fq) const {
        const int row0 = u.pm * BM + wr * 64 + fr, col0 = u.pn * HALF + wc * 32 + 8 * fq;
#pragma unroll
        for (int ai = 0; ai < 2; ++ai)
#pragma unroll
            for (int m = 0; m < 4; ++m) { bf16_t* p = H + (size_t)(row0 + ai * HALF + m * 16) * ldc + col0;
                const f32x4 g0 = acc[ai][0][m][0], g1 = acc[ai][0][m][1], u0 = acc[ai][1][m][0], u1 = acc[ai][1][m][1];
                const f32x2e a = swiglu_pk((f32x2e){g0[0], g0[1]}, (f32x2e){u0[0], u0[1]}), b = swiglu_pk((f32x2e){g0[2], g0[3]}, (f32x2e){u0[2], u0[3]});
                const f32x2e c = swiglu_pk((f32x2e){g1[0], g1[1]}, (f32x2e){u1[0], u1[1]}), d = swiglu_pk((f32x2e){g1[2], g1[3]}, (f32x2e){u1[2], u1[3]});
                u32x4 w; w.x = cvt_pk_bf16(a.x, a.y); w.y = cvt_pk_bf16(b.x, b.y); w.z = cvt_pk_bf16(c.x, c.y); w.w = cvt_pk_bf16(d.x, d.y);
                *(u32x4*)p = w; }
    }
};
struct EpiPlain {
    static constexpr bool PERM = true, AFTER_DRAIN = false;
    bf16_t* O; int ldc;
    __device__ __forceinline__ void operator()(const f32x4 (&acc)[2][2][4][2], const Unit& u, int wr, int wc, int fr, int fq) const {
        const int row0 = u.pm * BM + wr * 64 + fr, col0 = u.pn * BM + wc * 32 + 8 * fq;
#pragma unroll
        for (int ai = 0; ai < 2; ++ai)
#pragma unroll
            for (int m = 0; m < 4; ++m) { bf16_t* rowp = O + (size_t)(row0 + ai * HALF + m * 16) * ldc + col0;
#pragma unroll
                for (int bj = 0; bj < 2; ++bj) { const f32x4 v0 = acc[ai][bj][m][0], v1 = acc[ai][bj][m][1];
                    u32x4 w; w.x = cvt_pk_bf16(v0[0], v0[1]); w.y = cvt_pk_bf16(v0[2], v0[3]); w.z = cvt_pk_bf16(v1[0], v1[1]); w.w = cvt_pk_bf16(v1[2], v1[3]);
                    *(u32x4*)(rowp + bj * HALF) = w; } }
    }
};

constexpr float F8_SX = 8.0f, F8_SU = 256.0f, F8_SH = 8.0f, F8_SD = 1024.0f, F8_SY = 64.0f;
__device__ __forceinline__ unsigned pk4_fp8(float a, float b, float c, float d) {
    int w = 0; w = __builtin_amdgcn_cvt_pk_fp8_f32(a, b, w, false); w = __builtin_amdgcn_cvt_pk_fp8_f32(c, d, w, true); return (unsigned)w; }
__device__ __forceinline__ float clamp_f8(float v) { return __builtin_fminf(__builtin_fmaxf(v, -448.0f), 448.0f); }
struct EpiSwiGLU8 {
    static constexpr bool PERM = true, AFTER_DRAIN = false;
    unsigned char* H; int ldc;
    static __device__ __forceinline__ f32x2e h8(f32x2e g, f32x2e u) {
        constexpr float IS = 1.0f / (F8_SX * F8_SU);
        const f32x2e t = g * (-1.4426950408889634f * IS); f32x2e ex; ex.x = __builtin_amdgcn_exp2f(t.x); ex.y = __builtin_amdgcn_exp2f(t.y);
        const f32x2e d = ex + 1.0f; f32x2e s; s.x = __builtin_amdgcn_rcpf(d.x); s.y = __builtin_amdgcn_rcpf(d.y);
        f32x2e r = (g * u) * (s * (IS * IS * F8_SH)); r.x = __builtin_amdgcn_fmed3f(r.x, -448.0f, 448.0f); r.y = __builtin_amdgcn_fmed3f(r.y, -448.0f, 448.0f); return r; }
    __device__ __forceinline__ void operator()(const f32x4 (&acc)[2][2][4][2], const Unit& u, int wr, int wc, int fr, int fq) const {
        const int row0 = u.pm * BM + wr * 64 + fr, col0 = u.pn * HALF + wc * 32 + 8 * fq;
#pragma unroll
        for (int ai = 0; ai < 2; ++ai)
#pragma unroll
            for (int m = 0; m < 4; ++m) { unsigned char* p = H + (size_t)(row0 + ai * HALF + m * 16) * ldc + col0;
                const f32x4 g0 = acc[ai][0][m][0], g1 = acc[ai][0][m][1], u0 = acc[ai][1][m][0], u1 = acc[ai][1][m][1];
                const f32x2e a = h8((f32x2e){g0[0], g0[1]}, (f32x2e){u0[0], u0[1]}), b = h8((f32x2e){g0[2], g0[3]}, (f32x2e){u0[2], u0[3]});
                const f32x2e c = h8((f32x2e){g1[0], g1[1]}, (f32x2e){u1[0], u1[1]}), d = h8((f32x2e){g1[2], g1[3]}, (f32x2e){u1[2], u1[3]});
                u32x2 w; w.x = pk4_fp8(a.x, a.y, b.x, b.y); w.y = pk4_fp8(c.x, c.y, d.x, d.y);
                *(u32x2*)p = w; }
    }
};
struct EpiPlain8 {
    static constexpr bool PERM = true, AFTER_DRAIN = false;
    unsigned char* O; int ldc; float scale;
    __device__ __forceinline__ void operator()(const f32x4 (&acc)[2][2][4][2], const Unit& u, int wr, int wc, int fr, int fq) const {
        const int row0 = u.pm * BM + wr * 64 + fr, col0 = u.pn * BM + wc * 32 + 8 * fq;
#pragma unroll
        for (int ai = 0; ai < 2; ++ai)
#pragma unroll
            for (int m = 0; m < 4; ++m) { unsigned char* rowp = O + (size_t)(row0 + ai * HALF + m * 16) * ldc + col0;
#pragma unroll
                for (int bj = 0; bj < 2; ++bj) { f32x4 v0 = acc[ai][bj][m][0] * scale, v1 = acc[ai][bj][m][1] * scale;
#pragma unroll
                    for (int q = 0; q < 4; ++q) { v0[q] = __builtin_amdgcn_fmed3f(v0[q], -448.0f, 448.0f); v1[q] = __builtin_amdgcn_fmed3f(v1[q], -448.0f, 448.0f); }
                    u32x2 w; w.x = pk4_fp8(v0[0], v0[1], v0[2], v0[3]); w.y = pk4_fp8(v1[0], v1[1], v1[2], v1[3]);
                    *(u32x2*)(rowp + bj * HALF) = w; } }
    }
};
struct EpiPlainS {
    static constexpr bool PERM = true, AFTER_DRAIN = false;
    bf16_t* O; int ldc; float scale;
    __device__ __forceinline__ void operator()(const f32x4 (&acc)[2][2][4][2], const Unit& u, int wr, int wc, int fr, int fq) const {
        const int row0 = u.pm * BM + wr * 64 + fr, col0 = u.pn * BM + wc * 32 + 8 * fq;
#pragma unroll
        for (int ai = 0; ai < 2; ++ai)
#pragma unroll
            for (int m = 0; m < 4; ++m) { bf16_t* rowp = O + (size_t)(row0 + ai * HALF + m * 16) * ldc + col0;
#pragma unroll
                for (int bj = 0; bj < 2; ++bj) { const f32x4 v0 = acc[ai][bj][m][0] * scale, v1 = acc[ai][bj][m][1] * scale;
                    u32x4 w; w.x = cvt_pk_bf16(v0[0], v0[1]); w.y = cvt_pk_bf16(v0[2], v0[3]); w.z = cvt_pk_bf16(v1[0], v1[1]); w.w = cvt_pk_bf16(v1[2], v1[3]);
                    *(u32x4*)(rowp + bj * HALF) = w; } }
    }
};
template <class Epi, class Sched, bool ALIGN_EPI = false, bool SP2 = false, bool F8 = false>
__device__ __forceinline__ void gemm_phase(PG8_LAS unsigned char* lds, const Gemm g, const Sched& S, const Epi& E) {
    int tid_ = threadIdx.x; asm volatile("" : "+v"(tid_));
    const int tid = tid_, wid = __builtin_amdgcn_readfirstlane(tid >> 6), lane = tid & 63, wr = wid >> 2, wc = wid & 3, fr = lane & 15, fq = lane >> 4;
    const int K = F8 ? g.K / 2 : g.K  , nt = K / BK;
    unsigned voffA[2], voffB[2];
#pragma unroll
    for (int i = 0; i < 2; ++i) { int R, C; stage_rc(tid * 16 + i * 8192, R, C); const int Rb = Epi::PERM ? ((R & ~31) + perm32(R & 31)) : R;
        voffA[i] = (unsigned)(R * K + C) * 2u; voffB[i] = (unsigned)(Rb * K + C) * 2u; }
    const size_t kstep = (size_t)(BK * 2);
    const size_t hstep = (size_t)HALF * K * 2;
    const size_t tstep = 2 * hstep;
    const unsigned ldsw = (unsigned)wid * 1024u;
    const int aoff = lds_byte(wr * 64 + fr, fq * 8), boff = lds_byte(wc * 32 + fr, fq * 8);
#define PG8_SA(b, h) (((b) * 2 + (h)) * HTB)
#define PG8_SB(b, h) ((4 + (b) * 2 + (h)) * HTB)
#define PG8_STAGE(bufoff, gbase, voff) do { _Pragma("unroll") for (int _i = 0; _i < 2; ++_i) \
        __builtin_amdgcn_global_load_lds((const unsigned*)((const char*)(gbase) + (voff)[_i]), (PG8_LAS unsigned*)(lds + (bufoff) + ldsw + _i * 8192), 16, 0, 0); } while (0)
#define PG8_LDA(dst, b, h) do { _Pragma("unroll") for (int m = 0; m < 4; ++m) { if constexpr (F8) { const v4i_ lo_ = *(const PG8_LAS v4i_*)(lds + PG8_SA(b, h) + aoff + m * 2048), hi_ = *(const PG8_LAS v4i_*)(lds + PG8_SA(b, h) + aoff + m * 2048 + 1024); dst##8[m] = __builtin_shufflevector(lo_, hi_, 0, 1, 2, 3, 4, 5, 6, 7); } \
        else { _Pragma("unroll") for (int k = 0; k < 2; ++k) dst[m][k] = *(const PG8_LAS bf16x8*)(lds + PG8_SA(b, h) + aoff + m * 2048 + k * 1024); } } } while (0)
#define PG8_LDB(dst, b, h) do { _Pragma("unroll") for (int n = 0; n < 2; ++n) { if constexpr (F8) { const v4i_ lo_ = *(const PG8_LAS v4i_*)(lds + PG8_SB(b, h) + boff + n * 2048), hi_ = *(const PG8_LAS v4i_*)(lds + PG8_SB(b, h) + boff + n * 2048 + 1024); dst##8[n] = __builtin_shufflevector(lo_, hi_, 0, 1, 2, 3, 4, 5, 6, 7); } \
        else { _Pragma("unroll") for (int k = 0; k < 2; ++k) dst[n][k] = *(const PG8_LAS bf16x8*)(lds + PG8_SB(b, h) + boff + n * 2048 + k * 1024); } } } while (0)
#define PG8_MMA(ai, bj, At, Bt) do { __builtin_amdgcn_s_setprio(1); _Pragma("unroll") for (int m = 0; m < 4; ++m) _Pragma("unroll") for (int n = 0; n < 2; ++n) { \
        if constexpr (F8) asm volatile("v_mfma_scale_f32_16x16x128_f8f6f4 %0, %1, %2, %0, %3, %3 op_sel_hi:[0,0,0]" : "+v"(acc[ai][bj][m][n]) : "v"(Bt##8[n]), "v"(At##8[m]), "v"(f8scale_));   \
        else { _Pragma("unroll") for (int k = 0; k < 2; ++k) acc[ai][bj][m][n] = __builtin_amdgcn_mfma_f32_16x16x32_bf16(Bt[n][k], At[m][k], acc[ai][bj][m][n], 0, 0, 0); } } \
        __builtin_amdgcn_s_setprio(0); } while (0)
#define PG8_WAIT_V(n) asm volatile("s_waitcnt vmcnt(" #n ")" ::: "memory")
#define PG8_WAIT_L(n) asm volatile("s_waitcnt lgkmcnt(" #n ")" ::: "memory")
#define PG8_BAR __builtin_amdgcn_s_barrier()
#define PG8_SCHED __builtin_amdgcn_sched_barrier(0)
    Unit cur, nxt; int ui = 0;
    if (!S.next(0, cur)) return;
    f32x4 acc[2][2][4][2];
#pragma unroll
    for (int a = 0; a < 2; ++a)
#pragma unroll
        for (int b = 0; b < 2; ++b)
#pragma unroll
            for (int m = 0; m < 4; ++m)
#pragma unroll
                for (int n = 0; n < 2; ++n) acc[a][b][m][n] = (f32x4){0.f, 0.f, 0.f, 0.f};
    typedef int v4i_ __attribute__((ext_vector_type(4))); typedef int v8i_ __attribute__((ext_vector_type(8)));
    int f8scale_ = 0x7F7F7F7F; asm volatile("" : "+v"(f8scale_));
    bf16x8 At[4][2], B0[2][2], B1[2][2]; v8i_ At8[4], B08[2], B18[2];
    const char* cA = (const char*)g.A + (size_t)cur.am * tstep; const char* cB = (const char*)g.Bt + (size_t)cur.e * g.bstride + (size_t)cur.pn * tstep;
    S.a_ready(cur);
    if constexpr (SP2) {
        PG8_STAGE(PG8_SB(0, 0), cB, voffB); PG8_STAGE(PG8_SB(0, 1), cB + hstep, voffB); PG8_STAGE(PG8_SA(0, 0), cA, voffA); PG8_STAGE(PG8_SA(0, 1), cA + hstep, voffA);
        if (wr == 1) PG8_BAR;
        PG8_WAIT_V(2); PG8_BAR;
        PG8_STAGE(PG8_SB(1, 0), cB + kstep, voffB); PG8_STAGE(PG8_SA(1, 0), cA + kstep, voffA); PG8_STAGE(PG8_SB(1, 1), cB + hstep + kstep, voffB);
        PG8_WAIT_V(6); PG8_BAR;
    } else {
        PG8_STAGE(PG8_SB(0, 0), cB, voffB); PG8_STAGE(PG8_SA(0, 0), cA, voffA); PG8_STAGE(PG8_SB(0, 1), cB + hstep, voffB); PG8_STAGE(PG8_SA(0, 1), cA + hstep, voffA);
        if (wr == 1) PG8_BAR;
        PG8_WAIT_V(4); PG8_BAR;
        PG8_STAGE(PG8_SB(1, 0), cB + kstep, voffB); PG8_STAGE(PG8_SA(1, 0), cA + kstep, voffA); PG8_STAGE(PG8_SB(1, 1), cB + hstep + kstep, voffB);
        PG8_WAIT_V(6); PG8_BAR;
    }
    for (;;) {
        const bool has_next = S.next(ui + 1, nxt);
        const char* nA = has_next ? (const char*)g.A + (size_t)nxt.am * tstep : cA; const char* nB = has_next ? (const char*)g.Bt + (size_t)nxt.e * g.bstride + (size_t)nxt.pn * tstep : cB;
        for (int t = 0; t < nt; t += 2) {
            const bool last = (t == nt - 2);
            const char* a1 = cA + (size_t)(t + 1) * kstep;
            const char* a2 = last ? nA : cA + (size_t)(t + 2) * kstep; const char* b2 = last ? nB : cB + (size_t)(t + 2) * kstep;
            const char* a3 = a2 + kstep; const char* b3 = b2 + kstep;
            if (last && has_next) S.a_ready(nxt);
            if constexpr (SP2) {
            PG8_LDB(B0, 0, 0); PG8_LDB(B1, 0, 1); PG8_SCHED; PG8_LDA(At, 0, 0); PG8_STAGE(PG8_SA(1, 1), a1 + hstep, voffA);
            PG8_WAIT_V(8); PG8_WAIT_L(0); PG8_BAR; PG8_MMA(0, 0, At, B0); PG8_MMA(0, 1, At, B1); PG8_BAR; PG8_SCHED;
            PG8_LDA(At, 0, 1); PG8_STAGE(PG8_SB(0, 0), b2, voffB); PG8_STAGE(PG8_SB(0, 1), b2 + hstep, voffB); PG8_STAGE(PG8_SA(0, 0), a2, voffA);
            PG8_WAIT_V(8); PG8_WAIT_L(0); PG8_BAR; PG8_MMA(1, 0, At, B0); PG8_MMA(1, 1, At, B1); PG8_BAR; PG8_SCHED;
            PG8_LDB(B0, 1, 0); PG8_LDB(B1, 1, 1); PG8_SCHED; PG8_LDA(At, 1, 0); PG8_STAGE(PG8_SA(0, 1), a2 + hstep, voffA);
            PG8_WAIT_V(8); PG8_WAIT_L(0); PG8_BAR; PG8_MMA(0, 0, At, B0); PG8_MMA(0, 1, At, B1); PG8_BAR; PG8_SCHED;
            PG8_LDA(At, 1, 1); PG8_STAGE(PG8_SB(1, 0), b3, voffB); PG8_STAGE(PG8_SB(1, 1), b3 + hstep, voffB); PG8_STAGE(PG8_SA(1, 0), a3, voffA);
            PG8_WAIT_V(8); PG8_WAIT_L(0); PG8_BAR; PG8_MMA(1, 0, At, B0); PG8_MMA(1, 1, At, B1); PG8_BAR; PG8_SCHED;
            } else {
            PG8_LDB(B0, 0, 0); PG8_SCHED; PG8_LDA(At, 0, 0); PG8_STAGE(PG8_SA(1, 1), a1 + hstep, voffA);
            PG8_WAIT_L(8); PG8_BAR; PG8_WAIT_L(0); PG8_MMA(0, 0, At, B0); PG8_BAR; PG8_SCHED;
            PG8_LDB(B1, 0, 1); PG8_STAGE(PG8_SB(0, 0), b2, voffB);
            PG8_BAR; PG8_WAIT_L(0); PG8_MMA(0, 1, At, B1); PG8_BAR;
            PG8_LDA(At, 0, 1); PG8_STAGE(PG8_SA(0, 0), a2, voffA);
            PG8_BAR; PG8_WAIT_L(0); PG8_MMA(1, 0, At, B0); PG8_BAR; PG8_SCHED;
            PG8_STAGE(PG8_SB(0, 1), b2 + hstep, voffB);
            PG8_WAIT_V(6); PG8_BAR; PG8_MMA(1, 1, At, B1); PG8_BAR;
            PG8_LDB(B0, 1, 0); PG8_SCHED; PG8_LDA(At, 1, 0); PG8_STAGE(PG8_SA(0, 1), a2 + hstep, voffA);
            PG8_WAIT_L(8); PG8_BAR; PG8_WAIT_L(0); PG8_MMA(0, 0, At, B0); PG8_BAR; PG8_SCHED;
            PG8_LDB(B1, 1, 1); PG8_STAGE(PG8_SB(1, 0), b3, voffB);
            PG8_BAR; PG8_WAIT_L(0); PG8_MMA(0, 1, At, B1); PG8_BAR;
            PG8_LDA(At, 1, 1); PG8_STAGE(PG8_SA(1, 0), a3, voffA);
            PG8_BAR; PG8_WAIT_L(0); PG8_MMA(1, 0, At, B0); PG8_BAR; PG8_SCHED;
            PG8_STAGE(PG8_SB(1, 1), b3 + hstep, voffB);
            PG8_WAIT_V(6); PG8_BAR; PG8_MMA(1, 1, At, B1); PG8_BAR;
            }
        }
        if constexpr (F8) asm volatile("s_nop 15\n\ts_nop 7" ::: "memory");
        if constexpr (ALIGN_EPI) { if (wr == 0) PG8_BAR; }
        if constexpr (!Epi::AFTER_DRAIN) { E(acc, cur, wr, wc, fr, fq); S.done(cur); }
        if (!has_next) break;
#pragma unroll
        for (int a = 0; a < 2; ++a)
#pragma unroll
            for (int b = 0; b < 2; ++b)
#pragma unroll
                for (int m = 0; m < 4; ++m)
#pragma unroll
                    for (int n = 0; n < 2; ++n) acc[a][b][m][n] = (f32x4){0.f, 0.f, 0.f, 0.f};
        cur = nxt; cA = nA; cB = nB; ++ui;
        if constexpr (ALIGN_EPI) { if (wr == 1) PG8_BAR; }
    }
    PG8_WAIT_V(0);
    if constexpr (!ALIGN_EPI) { if (wr == 0) PG8_BAR; }
    PG8_BAR;
    if constexpr (Epi::AFTER_DRAIN) { E.fused(acc, cur, wr, wc, fr, fq, lds, wid, lane); S.done(cur); }
#undef PG8_SA
#undef PG8_SB
#undef PG8_STAGE
#undef PG8_LDA
#undef PG8_LDB
#undef PG8_MMA
#undef PG8_WAIT_V
#undef PG8_WAIT_L
#undef PG8_BAR
#undef PG8_SCHED
}
}
namespace attn_body {
using bf16=__hip_bfloat16;
using bf16x8=__attribute__((ext_vector_type(8)))short;
using s16x4=__attribute__((ext_vector_type(4)))short;
using f32x16=__attribute__((ext_vector_type(16)))float;
using u32x4=__attribute__((ext_vector_type(4)))unsigned;
constexpr int SEQ=8192,D=64,PIN=2816,POUT=1024;
constexpr int NW=8,QBLK=32,QB=QBLK*NW,KVBLK=64,NQB=SEQ/QB;
constexpr int ATTN_UNIT_ROWS=QB;
__device__ __forceinline__ int crow(int r,int hi){return (r&3)+8*(r>>2)+4*hi;}
#define SBAR() __builtin_amdgcn_sched_barrier(0)
__device__ __forceinline__ void bmask(f32x16&p0,f32x16&p1,int rel,int qrel,int hi,const __attribute__((address_space(3))) float*lut){
  const float NEG=-INFINITY; const int base=qrel-64*rel-4*hi;
  #pragma unroll
  for(int r=0;r<16;++r){ const int d0=base-((r&3)+8*(r>>2)), d1=d0-32;
    const int i0=d0<0?0:(d0>127?127:d0), i1=d1<0?0:(d1>127?127:d1);
    const float b0=lut[i0], b1=lut[i1];
    p0[r]=d0<0?NEG:p0[r]+b0; p1[r]=d1<0?NEG:p1[r]+b1; }
}
constexpr int NSLOT=3, SLOTB=8192;
constexpr int LDS_K=0, LDS_V=NSLOT*SLOTB, LDS_WS=2*NSLOT*SLOTB, LDS_OST=LDS_WS+NW*64*4, LDS_LUT=LDS_OST+NW*4096, LDS_BYTES=LDS_LUT+512;
constexpr float C2=0.125f*1.4426950408889634f;
template<int OFF> __device__ __forceinline__ void glds16s(unsigned voff,const void*sbase,unsigned lds_dst){unsigned keep;
  asm volatile("s_mov_b32 %0, m0\n\ts_mov_b32 m0, %3\n\ts_nop 4\n\tglobal_load_lds_dwordx4 %1, %2 offset:%c4\n\ts_mov_b32 m0, %0":"=&s"(keep):"v"(voff),"s"(sbase),"s"(lds_dst),"i"(OFF):"memory");}
__device__ __forceinline__ void glds16(const void*gsrc,unsigned lds_dst){unsigned keep;
  asm volatile("s_mov_b32 %0, m0\n\ts_mov_b32 m0, %2\n\ts_nop 0\n\tglobal_load_lds_dwordx4 %1, off\n\ts_mov_b32 m0, %0":"=&s"(keep):"v"(gsrc),"s"(lds_dst):"memory");}
__device__ __forceinline__ float max3f(float a,float b,float c){float r;asm("v_max3_f32 %0, %1, %2, %3":"=v"(r):"v"(a),"v"(b),"v"(c));return r;}
__device__ __forceinline__ float max2f(float a,float b){float r;asm("v_max_f32_e32 %0, %1, %2":"=v"(r):"v"(a),"v"(b));return r;}
__device__ __forceinline__ float fadd_s(float a,float b){float r;asm("v_add_f32_e32 %0, %1, %2":"=v"(r):"v"(a),"v"(b));return r;}
__device__ __forceinline__ float fsub_s(float a,float b){float r;asm("v_sub_f32_e32 %0, %1, %2":"=v"(r):"v"(a),"v"(b));return r;}
typedef float f32x2_t __attribute__((ext_vector_type(2))); typedef __bf16 bf16x2_t __attribute__((ext_vector_type(2)));
__device__ __forceinline__ unsigned cvtpk_s(float lo,float hi){f32x2_t v={lo,hi};bf16x2_t b=__builtin_convertvector(v,bf16x2_t);return __builtin_bit_cast(unsigned,b);}
#define WAIT_BAR(N) asm volatile("s_waitcnt vmcnt(" #N ") lgkmcnt(0)\n\ts_barrier":::"memory")

typedef __attribute__((address_space(3))) const char* lds_cptr;
typedef short v4i16_t __attribute__((ext_vector_type(4)));
__device__ __forceinline__ void kload8(bf16x8*kf,lds_cptr kp){
  kf[0]=*(const __attribute__((address_space(3))) bf16x8*)(kp);      kf[1]=*(const __attribute__((address_space(3))) bf16x8*)(kp+512);
  kf[2]=*(const __attribute__((address_space(3))) bf16x8*)(kp+2048); kf[3]=*(const __attribute__((address_space(3))) bf16x8*)(kp+2560);
  kf[4]=*(const __attribute__((address_space(3))) bf16x8*)(kp+4096); kf[5]=*(const __attribute__((address_space(3))) bf16x8*)(kp+4608);
  kf[6]=*(const __attribute__((address_space(3))) bf16x8*)(kp+6144); kf[7]=*(const __attribute__((address_space(3))) bf16x8*)(kp+6656);
}
__device__ __forceinline__ void kload2(bf16x8*kf,lds_cptr kp,int j){ kf[2*j]=*(const __attribute__((address_space(3))) bf16x8*)(kp+j*2048); kf[2*j+1]=*(const __attribute__((address_space(3))) bf16x8*)(kp+j*2048+512); }
__device__ __forceinline__ s16x4 vtr(lds_cptr p){ return __builtin_bit_cast(s16x4,__builtin_amdgcn_ds_read_tr16_b64_v4i16((__attribute__((address_space(3))) v4i16_t*)p)); }
__device__ __forceinline__ float rowmax(const f32x16&p0,const f32x16&p1){
  float a=max3f(p0[0],p0[1],p1[0]),b=max3f(p0[2],p0[3],p1[1]);a=max3f(a,p1[2],p1[3]);
  #pragma unroll
  for(int r=4;r<16;r+=4){a=max3f(a,p0[r],p0[r+1]);b=max3f(b,p0[r+2],p0[r+3]);a=max3f(a,p1[r],p1[r+1]);b=max3f(b,p1[r+2],p1[r+3]);}
  const float m=max2f(a,b);
  auto rr=__builtin_amdgcn_permlane32_swap(__float_as_uint(m),__float_as_uint(m),false,false);
  return max2f(__uint_as_float(rr[0]),__uint_as_float(rr[1]));
}
#ifndef ATTN_STORE16
#define ATTN_STORE16(p,v) (*(u32x4*)(p)=(v))
#endif
constexpr int VSLOTB=16384;
constexpr int W_K=0, W_V=NSLOT*SLOTB, W_WS=W_V+4*VSLOTB, W_OST=W_WS+NW*64*4, W_LUT=W_OST+NW*4096, W_BYTES=W_LUT+512;
static_assert(W_BYTES<=131072,"attention LDS");
__device__ __forceinline__ void qkt0(f32x16&p0,f32x16&p1,const char*Kslot,const bf16x8*qr,int r32,int hi){
  const char*kb=Kslot+hi*1024+r32*16; const f32x16 z=f32x16{};
  #pragma unroll
  for(int d0=0;d0<4;++d0){
    const bf16x8 b0=*reinterpret_cast<const bf16x8*>(kb+d0*2048);
    const bf16x8 b1=*reinterpret_cast<const bf16x8*>(kb+d0*2048+512);
    if(d0==0){p0=__builtin_amdgcn_mfma_f32_32x32x16_bf16(b0,qr[0],z,0,0,0);p1=__builtin_amdgcn_mfma_f32_32x32x16_bf16(b1,qr[0],z,0,0,0);}
    else{p0=__builtin_amdgcn_mfma_f32_32x32x16_bf16(b0,qr[d0],p0,0,0,0);p1=__builtin_amdgcn_mfma_f32_32x32x16_bf16(b1,qr[d0],p1,0,0,0);}}
}
__device__ __forceinline__ void pvw(f32x16*o,int vb,bf16x8 pa0,bf16x8 pa1,bf16x8 pa2,bf16x8 pa3){
  #pragma unroll
  for(int d0=0;d0<4;++d0){s16x4 lo[4],hi[4];
    #pragma unroll
    for(int ks=0;ks<4;++ks){
      asm volatile("ds_read_b64_tr_b16 %0,%1 offset:%c2":"=&v"(lo[ks]):"v"(vb),"i"(d0*4096+ks*1024):"memory");
      asm volatile("ds_read_b64_tr_b16 %0,%1 offset:%c2":"=&v"(hi[ks]):"v"(vb),"i"(d0*4096+ks*1024+512):"memory");}
    asm volatile("s_waitcnt lgkmcnt(0)":::"memory");SBAR();
    #define PK(k) (bf16x8){lo[k][0],lo[k][1],lo[k][2],lo[k][3],hi[k][0],hi[k][1],hi[k][2],hi[k][3]}
    o[d0]=__builtin_amdgcn_mfma_f32_32x32x16_bf16(pa0,PK(0),o[d0],0,0,0);
    o[d0]=__builtin_amdgcn_mfma_f32_32x32x16_bf16(pa1,PK(1),o[d0],0,0,0);
    o[d0]=__builtin_amdgcn_mfma_f32_32x32x16_bf16(pa2,PK(2),o[d0],0,0,0);
    o[d0]=__builtin_amdgcn_mfma_f32_32x32x16_bf16(pa3,PK(3),o[d0],0,0,0);
    #undef PK
  }
}
template<int THRL,class AX> __device__ __forceinline__ void attn_unit_w(int b,int qb,const bf16*Q,const bf16*__restrict__ K,const bf16*__restrict__ V,bf16*O,const float*rb,int hm,char*shm,bool pre,const bf16*Kn,const bf16*Vn,int bn,bool comb,int layer){
  int tid_=threadIdx.x; asm volatile("":"+v"(tid_)); const int tid=tid_,lane=tid&63,r32=lane&31,hi=lane>>5; const int wid=__builtin_amdgcn_readfirstlane(tid>>6);
  const long rowbase=(long)b*SEQ; const int q0=qb*QB;
  const bf16*Qw=Q+(rowbase+q0+wid*QBLK)*PIN;
  const bf16*Kh=K+rowbase*PIN,*Vh=V+rowbase*PIN;
  const unsigned lds0=(unsigned)(uintptr_t)shm;
  float*wsf=(float*)(shm+W_WS)+wid*64;
  const unsigned koff=(unsigned)((lane*PIN+wid*8)*2);
  const unsigned voff=(unsigned)(((16*(wid&3)+(lane>>2))*PIN+(wid>>2)*32+(lane&3)*8)*2);
  const unsigned kdst=lds0+W_K+wid*1024, vdst=lds0+W_V+wid*1024;
  #define DMA_K(t,slot) glds16s<0>(koff,Kh+(long)(t)*KVBLK*PIN,(unsigned)__builtin_amdgcn_readfirstlane(kdst+(slot)))
  #define VSL(t) ((((int)(t))&3)*VSLOTB)
  #define DMA_V(t) do{ glds16s<0>(voff,Vh+(long)(t)*KVBLK*PIN,(unsigned)__builtin_amdgcn_readfirstlane(vdst+VSL(t))); glds16s<0>(voff,(Vh+(long)(t)*KVBLK*PIN)+64,(unsigned)__builtin_amdgcn_readfirstlane(vdst+VSL(t)+8192)); }while(0)
  const int vb0=(int)(lds0+W_V)+((lane>>4)&1)*32+(lane&3)*8+(4*hi+((lane&15)>>2))*64;
  const char*Kbase=shm+W_K; bf16x8 kf[8];
  const lds_cptr shm3=(lds_cptr)shm; const lds_cptr kp0=shm3+W_K+hi*1024+r32*16; const lds_cptr vp0=shm3+W_V+((lane>>4)&1)*32+(lane&3)*8+(4*hi+((lane&15)>>2))*64;
  const __attribute__((address_space(3))) float*lut=(const __attribute__((address_space(3))) float*)(shm3+W_LUT);
  if(tid<128){ int bk=tid; if(tid>=16){ const float v=(__log2f((float)tid)-4.0f)*(16.0f/3.0f); bk=16+(int)v; bk=bk<31?bk:31; }
    ((__attribute__((address_space(3))) float*)(shm3+W_LUT))[tid]=(rb[bk*8+hm]-rb[31*8+hm])*1.4426950408889634f; }
  const int NT=(q0+QB)/KVBLK;
  if(!pre){DMA_K(0,0);}
  bf16x8 qr[4];
  #pragma unroll
  for(int d0=0;d0<4;++d0)qr[d0]=*reinterpret_cast<const bf16x8*>(&Qw[(long)r32*PIN+d0*16+hi*8]);
  float mhat=0.f,l_reg=0.f;f32x16 o[4];o[0]=f32x16{};o[1]=f32x16{};o[2]=f32x16{};o[3]=f32x16{};f32x16 negm=f32x16{};asm volatile("":"+v"(negm));
  const int qrel=wid*QBLK+r32;
  #define CMASK(P0,P1,t) do{int rel_=(t)-(NT-4); if(rel_>=-2)bmask(P0,P1,rel_,qrel,hi,lut);}while(0)
  bool resc=false;
  #define RESC() do{ if(resc){ asm volatile("s_waitcnt lgkmcnt(0)":::"memory"); \
      _Pragma("unroll") for(int d_=0;d_<4;++d_) _Pragma("unroll") for(int r=0;r<16;++r)o[d_][r]*=wsf[crow(r,hi)]; } }while(0)
  f32x16 pA0,pA1,pB0,pB1;
  int sl_prev=0,sl_cur=0,sl_next=SLOTB;
  #define ROT() do{sl_prev=sl_cur;sl_cur=sl_next;sl_next=(sl_next==(NSLOT-1)*SLOTB)?0:sl_next+SLOTB;}while(0)
  if(!pre){ DMA_V(0);DMA_K(1,SLOTB);DMA_V(1);DMA_K(2,2*SLOTB); WAIT_BAR(7); } else { WAIT_BAR(0); }
  qkt0(pA0,pA1,Kbase,qr,r32,hi);asm volatile("s_nop 15\n\ts_nop 7":"+v"(pA0),"+v"(pA1));CMASK(pA0,pA1,0);
  { const float rm=rowmax(pA0,pA1); mhat=rm;
    _Pragma("unroll") for(int r=0;r<16;++r){pA0[r]=fsub_s(pA0[r],rm);pA1[r]=fsub_s(pA1[r],rm);}
    _Pragma("unroll") for(int r=0;r<16;++r)negm[r]=-mhat; asm volatile("":"+v"(negm));
    _Pragma("unroll") for(int r=0;r<16;++r)pA0[r]=__builtin_amdgcn_exp2f(pA0[r]);
    _Pragma("unroll") for(int r=0;r<16;++r)pA1[r]=__builtin_amdgcn_exp2f(pA1[r]); }
  WAIT_BAR(3);
  DMA_K(3,0);DMA_V(2);
  ROT();
  kload8(kf,kp0+sl_cur);
  WAIT_BAR(3);
  s16x4 va_lo,va_hi,vb_lo,vb_hi,vc_lo,vc_hi,vd_lo,vd_hi,ve_lo,ve_hi; u32x4 pw0,pw1,pw2,pw3;
  #define PKW(P,B) cvtpk_s(P[B],P[B+1])
  #define PAF(k) __builtin_bit_cast(bf16x8,pw##k)
  #define VF(x) (bf16x8){x##_lo[0],x##_lo[1],x##_lo[2],x##_lo[3],x##_hi[0],x##_hi[1],x##_hi[2],x##_hi[3]}
  #define PIN(x) asm volatile("":"+v"(x))
  #define MX3(a,b,c) __builtin_fmaxf(__builtin_fmaxf((a),(b)),(c))
  #define MF32(A,B,C) __builtin_amdgcn_mfma_f32_32x32x16_bf16(A,B,C,0,0,0)
  #define GAPA(MF,A0,A1,A2,A3,W0,W1,PW) do{ MF; sacc+=A0; sacc+=A1; sacc+=A2; sacc+=A3; PIN(sacc); W0; W1; PIN(PW); SBAR(); }while(0)
  #define EX(v) __builtin_amdgcn_exp2f(v)
  #define VRW(x,i) do{ x##_lo=vtr(vp_+(((i)&3)*4096+((i)>>2)*1024)); x##_hi=vtr(vp_+(((i)&3)*4096+((i)>>2)*1024+512)); }while(0)
  #define GAPW(i,xc,xn,X,B) do{ if((i)+4<16){ VRW(xn,(i)+4); SBAR(); } o[(i)&3]=MF32(PAF_SEL(i),VF(xc),o[(i)&3]); X[B]=EX(X[B]); X[B+1]=EX(X[B+1]); PIN(X); SBAR(); }while(0)
  #define KRD(G,j) do{ if(G){ kload2(kf,kp0+sl_next,j); SBAR(); } }while(0)
  #define PAF_SEL(i) (((i)>>2)==0?PAF(0):((i)>>2)==1?PAF(1):((i)>>2)==2?PAF(2):PAF(3))
  #define STEPW(C0,C1,P0,P1,t,GK,GV,GL,PF) do{ SBAR(); \
    const lds_cptr vp_=vp0+VSL((t)-1); \
    float sacc=(P0[0]+P0[1]); \
    GAPA(C0=MF32(kf[0],qr[0],negm), P0[2],P0[3],P0[4],P0[5],     pw0[0]=PKW(P0,0), pw0[1]=PKW(P0,2), pw0); \
    GAPA(C1=MF32(kf[1],qr[0],negm), P0[6],P0[7],P0[8],P0[9],     pw0[2]=PKW(P0,4), pw0[3]=PKW(P0,6), pw0); \
    GAPA(C0=MF32(kf[2],qr[1],C0), P0[10],P0[11],P0[12],P0[13], pw1[0]=PKW(P0,8), pw1[1]=PKW(P0,10), pw1); \
    GAPA(C1=MF32(kf[3],qr[1],C1), P0[14],P0[15],P1[0],P1[1],   pw1[2]=PKW(P0,12),pw1[3]=PKW(P0,14), pw1); \
    GAPA(C0=MF32(kf[4],qr[2],C0), P1[2],P1[3],P1[4],P1[5],     pw2[0]=PKW(P1,0), pw2[1]=PKW(P1,2), pw2); \
    GAPA(C1=MF32(kf[5],qr[2],C1), P1[6],P1[7],P1[8],P1[9],     pw2[2]=PKW(P1,4), pw2[3]=PKW(P1,6), pw2); \
    GAPA(C0=MF32(kf[6],qr[3],C0), P1[10],P1[11],P1[12],P1[13], pw3[0]=PKW(P1,8), pw3[1]=PKW(P1,10), pw3); \
    GAPA(C1=MF32(kf[7],qr[3],C1), P1[14],P1[15],0.f,0.f,       pw3[2]=PKW(P1,12),pw3[3]=PKW(P1,14), pw3); \
    l_reg+=sacc; \
    VRW(va,0); VRW(vb,1); VRW(vc,2); VRW(vd,3); SBAR(); \
    CMASK(C0,C1,t); \
    { float a=MX3(C0[0],C0[1],C1[0]),b=MX3(C0[2],C0[3],C1[1]); a=MX3(a,C1[2],C1[3]); \
      _Pragma("unroll") for(int r=4;r<16;r+=4){a=MX3(a,C0[r],C0[r+1]);b=MX3(b,C0[r+2],C0[r+3]);a=MX3(a,C1[r],C1[r+1]);b=MX3(b,C1[r+2],C1[r+3]);} \
      float rm=__builtin_fmaxf(a,b); { auto rr=__builtin_amdgcn_permlane32_swap(__float_as_uint(rm),__float_as_uint(rm),false,false); rm=__builtin_fmaxf(__uint_as_float(rr[0]),__uint_as_float(rr[1])); } \
      resc=false; \
      if(__builtin_expect(__any(rm>(float)THRL),0)){ const float dl=__builtin_fmaxf(rm,0.f); mhat+=dl; \
        _Pragma("unroll") for(int r=0;r<16;++r){C0[r]-=dl;C1[r]-=dl;} \
        _Pragma("unroll") for(int r=0;r<16;++r)negm[r]=-mhat; asm volatile("":"+v"(negm)); \
        const float f=__builtin_amdgcn_exp2f(-dl); l_reg*=f; if(hi==0)wsf[r32]=f; resc=true; } } \
    if(GK){DMA_K((t)+3,sl_cur);} if(GV){DMA_V((t)+2);} \
    if(PF){ if(Kn){ const bf16*ksn=Kn+(long)bn*SEQ*PIN; const bf16*vsn=Vn+(long)bn*SEQ*PIN; \
        glds16s<0>(koff,ksn,(unsigned)__builtin_amdgcn_readfirstlane(kdst)); glds16s<0>(koff,ksn+(long)KVBLK*PIN,(unsigned)__builtin_amdgcn_readfirstlane(kdst+SLOTB)); glds16s<0>(koff,ksn+(long)2*KVBLK*PIN,(unsigned)__builtin_amdgcn_readfirstlane(kdst+2*SLOTB)); \
        glds16s<0>(voff,vsn,(unsigned)__builtin_amdgcn_readfirstlane(vdst)); glds16s<0>(voff,(vsn)+64,(unsigned)__builtin_amdgcn_readfirstlane(vdst+8192)); \
        glds16s<0>(voff,vsn+(long)KVBLK*PIN,(unsigned)__builtin_amdgcn_readfirstlane(vdst+VSLOTB)); glds16s<0>(voff,(vsn+(long)KVBLK*PIN)+64,(unsigned)__builtin_amdgcn_readfirstlane(vdst+VSLOTB+8192)); } } \
    SBAR(); \
    GAPW(0,va,ve,C0,0); GAPW(1,vb,va,C0,2); GAPW(2,vc,vb,C0,4); GAPW(3,vd,vc,C0,6); \
    KRD(GL,0); GAPW(4,ve,vd,C0,8); GAPW(5,va,ve,C0,10); KRD(GL,1); GAPW(6,vb,va,C0,12); GAPW(7,vc,vb,C0,14); \
    KRD(GL,2); GAPW(8,vd,vc,C1,0); GAPW(9,ve,vd,C1,2); KRD(GL,3); GAPW(10,va,ve,C1,4); GAPW(11,vb,va,C1,6); \
    GAPW(12,vc,vb,C1,8); GAPW(13,vd,vc,C1,10); GAPW(14,ve,vd,C1,12); GAPW(15,va,ve,C1,14); \
    }while(0)
  int t=1;
  #undef CMASK
  #define CMASK(P0,P1,t) do{}while(0)
  for(;t+7<NT;t+=2){
    STEPW(pB0,pB1,pA0,pA1,t,true,true,true,false);     WAIT_BAR(5); RESC(); ROT();
    STEPW(pA0,pA1,pB0,pB1,t+1,true,true,true,false);   WAIT_BAR(5); RESC(); ROT();
  }
  #undef CMASK
  #define CMASK(P0,P1,t) do{int rel_=(t)-(NT-4); if(rel_>=-2)bmask(P0,P1,rel_,qrel,hi,lut);}while(0)
  #define ENDW(tt) do{ if((tt)+3<NT){WAIT_BAR(5);} else if((tt)+2<NT){WAIT_BAR(4);} else {WAIT_BAR(0);} }while(0)
  for(;t+1<NT;t+=2){
    STEPW(pB0,pB1,pA0,pA1,t,(t+3<NT),(t+2<NT),(t+1<NT),false);       ENDW(t);   RESC(); ROT();
    STEPW(pA0,pA1,pB0,pB1,t+1,(t+4<NT),(t+3<NT),(t+2<NT),false);     ENDW(t+1); RESC(); ROT();
  }
  STEPW(pB0,pB1,pA0,pA1,NT-1,false,false,false,true); RESC();
  bf16*Ow=O+(rowbase+q0+wid*QBLK)*POUT; int ln_=lane; asm volatile("":"+v"(ln_)); const int ch=ln_&7,rw_=ln_>>3; u32x4 z0[2][4];
  if(comb){ const bf16*O0w=Ow+AX::O0_OFF;
    #pragma unroll
    for(int hf=0;hf<2;++hf)
      #pragma unroll
      for(int i=0;i<4;++i){const int row=i*8+rw_; z0[hf][i]=*(const u32x4*)(O0w+(long)row*POUT+hf*64+ch*8);} }
  { float sacc=pB0[0]+pB0[1]; _Pragma("unroll") for(int r=2;r<16;++r)sacc+=pB0[r]; _Pragma("unroll") for(int r=0;r<16;++r)sacc+=pB1[r]; l_reg+=sacc;
    pw0=(u32x4){PKW(pB0,0),PKW(pB0,2),PKW(pB0,4),PKW(pB0,6)};pw1=(u32x4){PKW(pB0,8),PKW(pB0,10),PKW(pB0,12),PKW(pB0,14)};pw2=(u32x4){PKW(pB1,0),PKW(pB1,2),PKW(pB1,4),PKW(pB1,6)};pw3=(u32x4){PKW(pB1,8),PKW(pB1,10),PKW(pB1,12),PKW(pB1,14)};
    SBAR(); pvw(o,vb0+VSL(NT-1),PAF(0),PAF(1),PAF(2),PAF(3)); }
  #undef PKW
  #undef PAF
  #undef VF
  #undef PIN
  #undef MX3
  #undef MF32
  #undef GAPA
  #undef GAPW
  #undef EX
  #undef VRW
  #undef KRD
  #undef PAF_SEL
  #undef STEPW
  #undef ENDW
  {auto rr=__builtin_amdgcn_permlane32_swap(__float_as_uint(l_reg),__float_as_uint(l_reg),false,false);l_reg=__uint_as_float(rr[0])+__uint_as_float(rr[1]);}
  if(hi==0)wsf[32+r32]=l_reg;asm volatile("s_waitcnt lgkmcnt(0)":::"memory");
  float rli[16];
  #pragma unroll
  for(int r=0;r<16;++r)rli[r]=__builtin_amdgcn_rcpf(wsf[32+crow(r,hi)]);
  if(!comb){
  #pragma unroll
  for(int hf=0;hf<2;++hf){ bf16*stg=(bf16*)(shm+W_OST)+wid*2048;
    #pragma unroll
    for(int r=0;r<16;++r){const int orow=crow(r,hi);
      #pragma unroll
      for(int d0=0;d0<2;++d0)stg[orow*64+d0*32+r32]=__float2bfloat16(o[2*hf+d0][r]*rli[r]);}
    asm volatile("s_waitcnt lgkmcnt(0)":::"memory");
    #pragma unroll
    for(int i=0;i<4;++i){const int row=i*8+(lane>>3),ch=lane&7; const u32x4 v=*(const u32x4*)(stg+row*64+ch*8); ATTN_STORE16(Ow+(long)row*POUT+hf*64+ch*8,v);}
    asm volatile("s_waitcnt lgkmcnt(0)":::"memory"); }
  } else {
    int ly=layer; asm volatile("":"+s"(ly));
    const float lam=AX::lam(ly,lane),post=AX::post(ly); const float*sg=AX::sg(ly);
    u32x4 z1[2][4];
    float g[2][8];
    #pragma unroll
    for(int hf=0;hf<2;++hf)
      #pragma unroll
      for(int k=0;k<8;++k)g[hf][k]=sg[hf*64+ch*8+k];
    #pragma unroll
    for(int hf=0;hf<2;++hf){ bf16*stg=(bf16*)(shm+W_OST)+wid*2048;
      #pragma unroll
      for(int r=0;r<16;++r){const int orow=crow(r,hi);
        #pragma unroll
        for(int d0=0;d0<2;++d0)stg[orow*64+d0*32+r32]=__float2bfloat16(o[2*hf+d0][r]*rli[r]);}
      asm volatile("s_waitcnt lgkmcnt(0)":::"memory");
      #pragma unroll
      for(int i=0;i<4;++i){const int row=i*8+rw_; z1[hf][i]=*(const u32x4*)(stg+row*64+ch*8);}
      asm volatile("s_waitcnt lgkmcnt(0)":::"memory"); }
    #pragma unroll
    for(int i=0;i<4;++i){const int row=i*8+rw_;
      float d[2][8]; float ss=0.f;
      #pragma unroll
      for(int hf=0;hf<2;++hf)
        #pragma unroll
        for(int k=0;k<4;++k){ const unsigned a=z0[hf][i][k],c=z1[hf][i][k];
          d[hf][2*k]=__uint_as_float(a<<16)-lam*__uint_as_float(c<<16); d[hf][2*k+1]=__uint_as_float(a&0xffff0000u)-lam*__uint_as_float(c&0xffff0000u);
          ss+=d[hf][2*k]*d[hf][2*k]+d[hf][2*k+1]*d[hf][2*k+1]; }
      ss+=__shfl_xor(ss,1); ss+=__shfl_xor(ss,2); ss+=__shfl_xor(ss,4);
      const float rn=post/sqrtf(ss*(1.f/128.f)+1e-6f);
      #pragma unroll
      for(int hf=0;hf<2;++hf){ u32x4 w;
        #pragma unroll
        for(int k=0;k<4;++k)w[k]=cvtpk_s(d[hf][2*k]*rn*g[hf][2*k],d[hf][2*k+1]*rn*g[hf][2*k+1]);
        ATTN_STORE16(Ow+(long)row*POUT+hf*64+ch*8,w); } }
  }
  asm volatile("s_waitcnt lgkmcnt(0)\n\ts_barrier":::"memory");
  #undef DMA_K
  #undef DMA_V
  #undef VSL
  #undef CMASK
  #undef RESC
  #undef ROT
}
template<int THRL,class AX> __device__ __forceinline__ void attn_phase_w(char*lds,const bf16*P,bf16*O,bf16*Y,const float*rb,int vcu,int layer,unsigned*qbase,volatile __attribute__((address_space(3))) unsigned*slot){
  const int s=vcu&7,bh=vcu>>3,b=bh>>2,h0=bh&3;
  int cur=31-s,h=h0,k=1; bool pre=false;
  while(cur>=0){ int nxt,hn=h;
    attn_unit_w<THRL,AX>(b,cur,P+0+(2*h)*64,P+512+(2*h)*64,P+1024+h*128,O+h*128,rb,h*2,lds,pre,P+512+(2*h+1)*64,P+1024+h*128,b,false,layer);
    if(k==1)nxt=16+s;
    else{ int d=16;
      for(int j=0;j<4&&d>=16;++j){ hn=(h0+j)&3; if(threadIdx.x==0)*slot=__hip_atomic_fetch_add(qbase+(b*4+hn)*32,1u,__ATOMIC_RELAXED,__HIP_MEMORY_SCOPE_AGENT); __syncthreads(); d=(int)__builtin_amdgcn_readfirstlane((int)*slot); __syncthreads(); }
      nxt=d<16?15-d:-1; }
    ++k;
    attn_unit_w<THRL,AX>(b,cur,P+0+(2*h+1)*64,P+512+(2*h+1)*64,P+1024+h*128,Y+h*128,rb,h*2+1,lds,true,(nxt>=0)?P+512+(2*hn)*64:nullptr,P+1024+hn*128,b,true,layer);
    pre=true; cur=nxt; h=hn; }
}
#undef SBAR
#undef WAIT_BAR
}

namespace ret {
typedef short bf16x8 __attribute__((ext_vector_type(8)));
typedef short bf16x4 __attribute__((ext_vector_type(4)));
typedef float f32x16 __attribute__((ext_vector_type(16)));
typedef unsigned u32x4 __attribute__((ext_vector_type(4)));
typedef float f32x4 __attribute__((ext_vector_type(4)));
typedef float f32x2 __attribute__((ext_vector_type(2)));
#define RLAS __attribute__((address_space(3)))
constexpr int QPB = 144, VPB = 272;
constexpr int R3_QL = 0, R3_KL = 18432, R3_VT = 36864, R3_ST = 54272, R3_STAT = 63488, R3_YS = 65536, YSP = 68;
constexpr int R1_KT = 0, R1_VT = 17408, R1_RED = 34816;
__device__ __forceinline__ int crow(int r, int hi) { return (r & 3) + 8 * (r >> 2) + 4 * hi; }
__device__ __forceinline__ unsigned pkbf(float lo, float hi) { typedef float v2f __attribute__((ext_vector_type(2))); typedef __bf16 v2b __attribute__((ext_vector_type(2))); v2f v = {lo, hi}; v2b b = __builtin_convertvector(v, v2b); return __builtin_bit_cast(unsigned, b); }
__device__ __forceinline__ void put_transposed(RLAS unsigned char* img, int dim0, int token, u32x4 w) {
    RLAS unsigned short* p = (RLAS unsigned short*)(img + dim0 * VPB + token * 2);
    p[0 * (VPB / 2)] = (unsigned short)w.x; p[1 * (VPB / 2)] = (unsigned short)(w.x >> 16); p[2 * (VPB / 2)] = (unsigned short)w.y; p[3 * (VPB / 2)] = (unsigned short)(w.y >> 16);
    p[4 * (VPB / 2)] = (unsigned short)w.z; p[5 * (VPB / 2)] = (unsigned short)(w.z >> 16); p[6 * (VPB / 2)] = (unsigned short)w.w; p[7 * (VPB / 2)] = (unsigned short)(w.w >> 16);
}
__device__ __forceinline__ void ret_kv_units(RLAS unsigned char* lds, const unsigned short* P, float* AT, int u0, int ustep, int nunits) {
    int tid = threadIdx.x; asm volatile("" : "+v"(tid)); const int lane = tid & 63, wave = __builtin_amdgcn_readfirstlane(tid >> 6), r32 = lane & 31, hi = lane >> 5;
    const int tl = wave & 3, eb = tl >> 1, db = tl & 1, kh = wave >> 2;
    u32x4 kw[2], vw[2];
#define RKV_LOAD(unit_) do { const int c_ = (unit_) & 63, h_ = ((unit_) >> 6) & 3, b_ = (unit_) >> 8; const size_t row0_ = (size_t)b_ * 8192 + (size_t)c_ * 128; \
        _Pragma("unroll") for (int jx = 0; jx < 2; ++jx) { const int ci = tid + 512 * jx, token = ci & 127, c8 = ci >> 7; \
            kw[jx] = *(const u32x4*)(P + (row0_ + token) * 2816 + 2048 + h_ * 64 + c8 * 8); vw[jx] = *(const u32x4*)(P + (row0_ + token) * 2816 + 2304 + h_ * 64 + c8 * 8); } } while (0)
    if (u0 < nunits) RKV_LOAD(u0);
    for (int unit = u0; unit < nunits; unit += ustep) {
        __syncthreads();
#pragma unroll
        for (int jx = 0; jx < 2; ++jx) { const int ci = tid + 512 * jx, token = ci & 127, c8 = ci >> 7;
            put_transposed(lds + R1_KT, c8 * 8, token, kw[jx]); put_transposed(lds + R1_VT, c8 * 8, token, vw[jx]); }
        if (unit + ustep < nunits) RKV_LOAD(unit + ustep);
        __syncthreads();
        f32x16 acc = {};
#pragma unroll
        for (int s = 0; s < 4; ++s) { const int ks = kh * 4 + s;
            const bf16x8 a = *(const RLAS bf16x8*)(lds + R1_VT + (32 * eb + r32) * VPB + (16 * ks + 8 * hi) * 2);
            const bf16x8 bb = *(const RLAS bf16x8*)(lds + R1_KT + (32 * db + r32) * VPB + (16 * ks + 8 * hi) * 2);
            acc = __builtin_amdgcn_mfma_f32_32x32x16_bf16(a, bb, acc, 0, 0, 0); }
        RLAS f32x4* red = (RLAS f32x4*)(lds + R1_RED + tl * 4096) + lane * 4;
        if (kh == 1) { red[0] = (f32x4){acc[0], acc[1], acc[2], acc[3]}; red[1] = (f32x4){acc[4], acc[5], acc[6], acc[7]}; red[2] = (f32x4){acc[8], acc[9], acc[10], acc[11]}; red[3] = (f32x4){acc[12], acc[13], acc[14], acc[15]}; }
        __syncthreads();
        if (kh == 0) { float* out = AT + (size_t)unit * 4096 + 32 * db + r32;
#pragma unroll
            for (int q = 0; q < 4; ++q) { const f32x4 o = red[q];
#pragma unroll
                for (int x = 0; x < 4; ++x) { const int r = 4 * q + x; out[(32 * eb + crow(r, hi)) * 64] = acc[r] + o[x]; } } }
    }
#undef RKV_LOAD
}
__device__ __forceinline__ void ret_out_unit(RLAS unsigned char* lds, const unsigned short* P, unsigned short* Y, const float* AT, const float* gn_g  , int unit) {
    int tid = threadIdx.x; asm volatile("" : "+v"(tid)); const int lane = tid & 63, wave = __builtin_amdgcn_readfirstlane(tid >> 6), r32 = lane & 31, hi = lane >> 5;
    const int g = unit & 7, h = (unit >> 3) & 3, b = unit >> 5;
    const float lg = pg8::lg2_gamma(h), gamma = __builtin_amdgcn_exp2f(lg), g127 = __builtin_amdgcn_exp2f(127.0f * lg), g128 = __builtin_amdgcn_exp2f(128.0f * lg);
    const size_t rowb = (size_t)b * 8192;
    const float* ATh = AT + (size_t)((b * 4 + h) * 64) * 4096 + tid * 8;
    u32x4 qreg[2], kreg[2], vreg[2];
#pragma unroll
    for (int jx = 0; jx < 2; ++jx) { const int ci = tid + 512 * jx; const size_t rq = rowb + (size_t)(8 * g) * 128 + (ci >> 3), rv = rowb + (size_t)(8 * g) * 128 + (ci & 127);
        qreg[jx] = *(const u32x4*)(P + rq * 2816 + 1792 + h * 64 + (ci & 7) * 8); kreg[jx] = *(const u32x4*)(P + rq * 2816 + 2048 + h * 64 + (ci & 7) * 8);
        vreg[jx] = *(const u32x4*)(P + rv * 2816 + 2304 + h * 64 + (ci >> 7) * 8); }
    float S[8];
#pragma unroll
    for (int x = 0; x < 8; ++x) S[x] = 0.f;
#pragma unroll 8
    for (int cp = 0; cp < 8 * g; ++cp) { const f32x4 a0 = *(const f32x4*)(ATh + (size_t)cp * 4096), a1 = *(const f32x4*)(ATh + (size_t)cp * 4096 + 4);
        S[0] = g128 * S[0] + g127 * a0[0]; S[1] = g128 * S[1] + g127 * a0[1]; S[2] = g128 * S[2] + g127 * a0[2]; S[3] = g128 * S[3] + g127 * a0[3];
        S[4] = g128 * S[4] + g127 * a1[0]; S[5] = g128 * S[5] + g127 * a1[1]; S[6] = g128 * S[6] + g127 * a1[2]; S[7] = g128 * S[7] + g127 * a1[3]; }
    const int ib = wave >> 1, eh = wave & 1;
    for (int cc = 0; cc < 8; ++cc) {
        const int c = 8 * g + cc; const size_t row0 = rowb + (size_t)c * 128;
        const f32x4 n0 = *(const f32x4*)(ATh + (size_t)c * 4096), n1 = *(const f32x4*)(ATh + (size_t)c * 4096 + 4);
        u32x4 sgr[2];
#pragma unroll
        for (int jx = 0; jx < 2; ++jx) { const int ci = tid + 512 * jx; sgr[jx] = *(const u32x4*)(P + (row0 + (ci >> 3)) * 2816 + 2560 + h * 64 + (ci & 7) * 8); }
        __syncthreads();
#pragma unroll
        for (int jx = 0; jx < 2; ++jx) { const int ci = tid + 512 * jx;
            { const int row = ci >> 3, c8 = ci & 7; *(RLAS u32x4*)(lds + R3_QL + row * QPB + c8 * 16) = qreg[jx]; *(RLAS u32x4*)(lds + R3_KL + row * QPB + c8 * 16) = kreg[jx]; }
            { const int token = ci & 127, c8 = ci >> 7; put_transposed(lds + R3_VT, c8 * 8, token, vreg[jx]); } }
        { u32x4 sw; sw.x = pkbf(gamma * S[0], gamma * S[1]); sw.y = pkbf(gamma * S[2], gamma * S[3]); sw.z = pkbf(gamma * S[4], gamma * S[5]); sw.w = pkbf(gamma * S[6], gamma * S[7]);
          *(RLAS u32x4*)(lds + R3_ST + (tid >> 3) * QPB + (tid & 7) * 16) = sw; }
        if (cc < 7) {
#pragma unroll
            for (int jx = 0; jx < 2; ++jx) { const int ci = tid + 512 * jx; const size_t rq = row0 + 128 + (ci >> 3), rv = row0 + 128 + (ci & 127);
                qreg[jx] = *(const u32x4*)(P + rq * 2816 + 1792 + h * 64 + (ci & 7) * 8); kreg[jx] = *(const u32x4*)(P + rq * 2816 + 2048 + h * 64 + (ci & 7) * 8);
                vreg[jx] = *(const u32x4*)(P + rv * 2816 + 2304 + h * 64 + (ci >> 7) * 8); } }
        __syncthreads();
        bf16x8 bq[4];
#pragma unroll
        for (int ks = 0; ks < 4; ++ks) bq[ks] = *(const RLAS bf16x8*)(lds + R3_QL + (32 * ib + r32) * QPB + (16 * ks + 8 * hi) * 2);
        f32x16 yt = {};
        for (int jb = 0; jb <= ib; ++jb) {
            f32x16 x = {};
#pragma unroll
            for (int ks = 0; ks < 4; ++ks) { const bf16x8 ka = *(const RLAS bf16x8*)(lds + R3_KL + (32 * jb + r32) * QPB + (16 * ks + 8 * hi) * 2); x = __builtin_amdgcn_mfma_f32_32x32x16_bf16(ka, bq[ks], x, 0, 0, 0); }
            if (jb == ib) {
#pragma unroll
                for (int r = 0; r < 16; ++r) if (crow(r, hi) > r32) x[r] = 0.f; }
#pragma unroll
            for (int s = 0; s < 2; ++s) {
                u32x4 xw; xw.x = pkbf(x[8 * s], x[8 * s + 1]); xw.y = pkbf(x[8 * s + 2], x[8 * s + 3]); xw.z = pkbf(x[8 * s + 4], x[8 * s + 5]); xw.w = pkbf(x[8 * s + 6], x[8 * s + 7]);
                const RLAS unsigned char* vp = lds + R3_VT + (32 * eh + r32) * VPB + (32 * jb + 16 * s + 4 * hi) * 2;
                const bf16x4 v0 = *(const RLAS bf16x4*)vp, v1 = *(const RLAS bf16x4*)(vp + 16);
                const bf16x8 va = {v0[0], v0[1], v0[2], v0[3], v1[0], v1[1], v1[2], v1[3]};
                yt = __builtin_amdgcn_mfma_f32_32x32x16_bf16(va, __builtin_bit_cast(bf16x8, xw), yt, 0, 0, 0); }
        }
#pragma unroll
        for (int ks = 0; ks < 4; ++ks) { const bf16x8 sa = *(const RLAS bf16x8*)(lds + R3_ST + (32 * eh + r32) * QPB + (16 * ks + 8 * hi) * 2); yt = __builtin_amdgcn_mfma_f32_32x32x16_bf16(sa, bq[ks], yt, 0, 0, 0); }
        float s1 = 0.f, s2 = 0.f;
#pragma unroll
        for (int r = 0; r < 16; ++r) { s1 += yt[r]; s2 += yt[r] * yt[r]; }
        s1 += __shfl_xor(s1, 32); s2 += __shfl_xor(s2, 32);
        RLAS f32x2* stat = (RLAS f32x2*)(lds + R3_STAT);
        if (hi == 0) stat[eh * 128 + 32 * ib + r32] = (f32x2){s1, s2};
        __syncthreads();
        { const f32x2 sa = stat[32 * ib + r32], sb = stat[128 + 32 * ib + r32];
          const float mean = (sa.x + sb.x) * (1.f / 64.f), var = fmaxf((sa.y + sb.y) * (1.f / 64.f) - mean * mean, 0.f), rstd = 1.0f / sqrtf(var + 1e-6f);
          RLAS float* ys = (RLAS float*)(lds + R3_YS) + (32 * ib + r32) * YSP + 32 * eh;
#pragma unroll
          for (int r = 0; r < 16; ++r) ys[crow(r, hi)] = (yt[r] - mean) * rstd; }
        S[0] = g128 * S[0] + g127 * n0[0]; S[1] = g128 * S[1] + g127 * n0[1]; S[2] = g128 * S[2] + g127 * n0[2]; S[3] = g128 * S[3] + g127 * n0[3];
        S[4] = g128 * S[4] + g127 * n1[0]; S[5] = g128 * S[5] + g127 * n1[1]; S[6] = g128 * S[6] + g127 * n1[2]; S[7] = g128 * S[7] + g127 * n1[3];
        __syncthreads();
#pragma unroll
        for (int jx = 0; jx < 2; ++jx) { const int ci = tid + 512 * jx, row = ci >> 3, c8 = ci & 7;
            const RLAS float* ys = (const RLAS float*)(lds + R3_YS) + row * YSP + c8 * 8; const f32x4 y0 = *(const RLAS f32x4*)ys, y1 = *(const RLAS f32x4*)(ys + 4);
            const f32x4 g0 = *(const f32x4*)(gn_g + h * 64 + c8 * 8), g1 = *(const f32x4*)(gn_g + h * 64 + c8 * 8 + 4);
            const u32x4 sg = sgr[jx];
            u32x4 o;
            o.x = pkbf(y0[0] * g0[0] * __uint_as_float(sg.x << 16), y0[1] * g0[1] * __uint_as_float(sg.x & 0xffff0000u)); o.y = pkbf(y0[2] * g0[2] * __uint_as_float(sg.y << 16), y0[3] * g0[3] * __uint_as_float(sg.y & 0xffff0000u));
            o.z = pkbf(y1[0] * g1[0] * __uint_as_float(sg.z << 16), y1[1] * g1[1] * __uint_as_float(sg.z & 0xffff0000u)); o.w = pkbf(y1[2] * g1[2] * __uint_as_float(sg.w << 16), y1[3] * g1[3] * __uint_as_float(sg.w & 0xffff0000u));
            *(u32x4*)(Y + (row0 + row) * 1024 + 768 + h * 64 + c8 * 8) = o; }
    }
}
#undef RLAS
}
#define GAS __attribute__((address_space(1)))
#define LAS __attribute__((address_space(3)))
typedef unsigned short bf16;
typedef unsigned v4u __attribute__((ext_vector_type(4)));
typedef float f32x4 __attribute__((ext_vector_type(4)));
typedef short bf16x8 __attribute__((ext_vector_type(8)));
typedef GAS unsigned gu32;
typedef GAS unsigned long long gu64;
#define RLX_AGENT __ATOMIC_RELAXED, __HIP_MEMORY_SCOPE_AGENT
#define LDS_WAIT() asm volatile("s_waitcnt lgkmcnt(0)" ::: "memory")
#define VM_WAIT() asm volatile("s_waitcnt vmcnt(0)" ::: "memory")
__device__ __forceinline__ unsigned long long rt() { return __builtin_amdgcn_s_memrealtime(); }
__device__ __forceinline__ unsigned f2bf(float f) { unsigned u = __builtin_bit_cast(unsigned, f); return (u + 0x7fffu + ((u >> 16) & 1u)) >> 16; }
__device__ __forceinline__ unsigned pk2(float lo, float hi) { return f2bf(lo) | (f2bf(hi) << 16); }

#define XB_TMO      128
#define XB_XCNT(j)  (256  + 64 * (j))
#define XB_XSUB(j)  (1280 + 64 * (j))
#define XB_XGEN(j)  (2304 + 64 * (j))
#define XB_TOP      3328
#define XB_TOPGEN   3392
#define XCD_BAR_WORDS 3456
#define XB_SPIN_CAP (1u << 22)

__device__ __forceinline__ unsigned xb_ld(unsigned* p)              { return __hip_atomic_load(p, __ATOMIC_RELAXED, __HIP_MEMORY_SCOPE_AGENT); }
__device__ __forceinline__ unsigned xb_add(unsigned* p, unsigned v) { return __hip_atomic_fetch_add(p, v, __ATOMIC_RELAXED, __HIP_MEMORY_SCOPE_AGENT); }
__device__ __forceinline__ unsigned xb_xcc_id() { return (unsigned)__builtin_amdgcn_s_getreg((3 << 11) | 20) & 0xFu; }
#define XB_SPIN(cond, bar) do { unsigned _sp = 0; while (cond) { __builtin_amdgcn_s_sleep(1); \
    if ((++_sp & 255u) == 0u) { if (xb_ld(&(bar)[XB_TMO])) break; if (_sp > XB_SPIN_CAP) { atomicAdd(&(bar)[XB_TMO], 1u); break; } } } } while (0)

struct XcdBarrier {
    unsigned* bar; unsigned x;
    volatile LAS unsigned* st;
};

__device__ __forceinline__ XcdBarrier xcd_barrier_post(unsigned* bar, volatile LAS unsigned* st) {
    XcdBarrier b; b.bar = bar; b.x = xb_xcc_id(); b.st = st;
    if (threadIdx.x == 0) (void)xb_add(&bar[XB_XCNT(b.x)], 1u);
    return b;
}
__device__ __forceinline__ void xcd_barrier_complete(unsigned* bar, unsigned x, unsigned& nloc, unsigned& nx) {
    const unsigned G = gridDim.x * gridDim.y * gridDim.z;
    unsigned sum, cnt, mine, sp = 0u;
    for (;;) {
        sum = 0u; cnt = 0u; mine = 0u;
#pragma unroll
        for (unsigned j = 0; j < 16; ++j) { const unsigned c = xb_ld(&bar[XB_XCNT(j)]); sum += c; cnt += (c > 0u) ? 1u : 0u; mine = (j == x) ? c : mine; }
        if (sum == G) break;
        __builtin_amdgcn_s_sleep(1);
        if ((++sp & 255u) == 0u) { if (xb_ld(&bar[XB_TMO])) break; if (sp > XB_SPIN_CAP) { atomicAdd(&bar[XB_TMO], 1u); break; } }
    }
    nloc = mine > 0u ? mine : 1u; nx = cnt > 0u ? cnt : 1u;
}

__device__ __forceinline__ void xcd_barrier(const XcdBarrier& b) {
    asm volatile("s_waitcnt vmcnt(0)" ::: "memory");
    __syncthreads();
    if (threadIdx.x == 0) {
#ifdef PROBE_BARWAIT
        const unsigned long long pbw_t0 = __builtin_amdgcn_s_memrealtime();
#endif
        unsigned* bar = b.bar;
        __builtin_amdgcn_s_waitcnt(0);
        unsigned nloc = b.st[0], nx = b.st[1];
        if (nloc == 0u) { xcd_barrier_complete(bar, b.x, nloc, nx); b.st[0] = nloc; b.st[1] = nx; }
        const unsigned old = xb_add(&bar[XB_XSUB(b.x)], 1u);
        const unsigned gen = old / nloc;
        if (old + 1u == (gen + 1u) * nloc) {
            __builtin_amdgcn_fence(__ATOMIC_RELEASE, "agent");
            asm volatile("s_waitcnt vmcnt(0)" ::: "memory");
            const unsigned og = xb_add(&bar[XB_TOP], 1u);
            const unsigned tg = og / nx;
            if (og + 1u == (tg + 1u) * nx) xb_add(&bar[XB_TOPGEN], 1u);
            else XB_SPIN(xb_ld(&bar[XB_TOPGEN]) == tg, bar);
            __builtin_amdgcn_fence(__ATOMIC_ACQUIRE, "agent");
            xb_add(&bar[XB_XGEN(b.x)], 1u);
            asm volatile("s_waitcnt vmcnt(0)" ::: "memory");
        } else {
            XB_SPIN(xb_ld(&bar[XB_XGEN(b.x)]) == gen, bar);
            __builtin_amdgcn_fence(__ATOMIC_ACQUIRE, "agent");
            asm volatile("s_waitcnt vmcnt(0)" ::: "memory");
        }
#ifdef PROBE_BARWAIT
        { const unsigned j_ = b.st[9]; b.st[9] = j_ + 1u; if ((PROBE_BARMASK >> j_) & 1u) b.st[8] += (unsigned)(__builtin_amdgcn_s_memrealtime() - pbw_t0); }
#endif
    }
    __syncthreads();
}

constexpr int NWAVES = 8, NTHR = NWAVES * 64;
constexpr int BATCH = 8, SEQ = 8192, DM = 1024, MROWS = BATCH * SEQ;
constexpr int INW = 2816, FFD = 2816, NEXP = 8, EDIM = 3584, DEPTH = 2;
constexpr int PC_Q = 0, PC_K = 512, PC_V = 1024, PC_POOL = 1536, PC_RQ = 1792, PC_RK = 2048, PC_RV = 2304, PC_RG = 2560;
constexpr float LN_EPS = 1e-5f, NORM_EPS = 1e-6f, ALPHA = 1.4142135623730951f, LOG2E = 1.4426950408889634f;
constexpr int QTILES = 192, QLAST = 128, QMID_MAX = 200;
constexpr int MAXTILES = (MROWS * 2) / 256 + NEXP;

constexpr size_t MiB = 1u << 20;
constexpr size_t WS_CTL = 0, CTL_ZERO_BYTES = 1 * MiB;
constexpr size_t WS_RE = 1 * MiB;
constexpr size_t WS_RG = WS_RE + 512 * 1024;
constexpr size_t WS_RS = WS_RG + 512 * 1024;
constexpr size_t WS_BC = WS_RS + 512 * 1024;
constexpr size_t WS_MI = WS_BC + 16 * 1024;
constexpr size_t WS_W = 8 * MiB;
constexpr size_t WS_WIN = WS_W;
constexpr size_t WS_WOUT = WS_WIN + 2 * (size_t)INW * DM * 2;
constexpr size_t WS_WGU = WS_WOUT + 2 * (size_t)DM * DM * 2;
constexpr size_t WS_WD = WS_WGU + 2 * (size_t)FFD * DM * 2;
constexpr size_t WS_MGU = WS_WD + (size_t)FFD * DM * 2;
constexpr size_t WS_MD = WS_MGU + (size_t)NEXP * 2 * EDIM * DM * 2;
constexpr size_t WS_WEND = WS_MD + (size_t)NEXP * EDIM * DM * 2;
constexpr size_t WS_XB = 208 * MiB;
constexpr size_t WS_Y = 336 * MiB;
constexpr size_t WS_P = 464 * MiB;
constexpr size_t WS_O = 816 * MiB;
constexpr size_t WS_AT = 944 * MiB;
constexpr size_t WS_END = 976 * MiB;
constexpr size_t WS_HQ = WS_XB;
constexpr size_t WS_HQ8 = WS_XB;
constexpr size_t WS_HQ8B = 636 * MiB;
constexpr size_t WS_XG8 = 376 * MiB;
constexpr size_t WS_XG = 506 * MiB;
static_assert(WS_WEND <= WS_XB, "weights fit");
static_assert(QTILES + QMID_MAX + QLAST >= MAXTILES && MAXTILES - NEXP - QTILES - QLAST == QTILES, "chunks cover every row tile");
static_assert((size_t)MAXTILES * 256 * DM * 2 <= WS_O - WS_P, "slot rows fit");
static_assert(WS_HQ8 + (size_t)QTILES * 256 * EDIM <= WS_XG8 && WS_XG8 + (size_t)MAXTILES * 256 * DM <= WS_XG && WS_XG + (size_t)MAXTILES * 256 * DM <= WS_HQ8B && WS_HQ8B + (size_t)QMID_MAX * 256 * EDIM <= WS_O, "fp8 expert buffers fit");
constexpr int CW_R1 = 3200, CW_R3Q = 3328, CW_PLQ = 3456;
constexpr int CW_TMO = 0, CW_ATQ = 1024, CW_BAR = 4096;

constexpr int RING_OFF = 0, RING_BYTES = 131072;
constexpr int LDSCTL_OFF = RING_BYTES, MISC_OFF = LDSCTL_OFF + 320;
constexpr int LDSTE_OFF = MISC_OFF + 128;
constexpr int LDS_BYTES = 147456;


struct Frame {
    LAS unsigned char* lds;
    volatile LAS unsigned* MISC;
    gu32* ctl;
    int vcu, G;
    float* out; unsigned char* ws;
};
__device__ __forceinline__ const float* inp(int k) { const __attribute__((address_space(4))) unsigned char* ka = (const __attribute__((address_space(4))) unsigned char*)__builtin_amdgcn_kernarg_segment_ptr(); asm volatile("" : "+s"(ka)); return *(const float* const __attribute__((address_space(4)))*)(ka + 8 * k); }
#define LANE_DECL int tid = threadIdx.x; asm volatile("" : "+v"(tid)); const int lane = tid & 63, wave = __builtin_amdgcn_readfirstlane(tid >> 6); (void)lane; (void)wave
__device__ __forceinline__ float wave_sum(float v) {
#pragma unroll
    for (int o = 1; o < 64; o <<= 1) v += __shfl_xor(v, o);
    return v;
}
__device__ __forceinline__ float bflo(unsigned w) { return __uint_as_float(w << 16); }
__device__ __forceinline__ float bfhi(unsigned w) { return __uint_as_float(w & 0xffff0000u); }
__device__ __forceinline__ float bf2f(bf16 h) { return __uint_as_float((unsigned)h << 16); }

template <bool VEC, class SrcFn>
__device__ __forceinline__ void p0_item(int K, int nblk, size_t ldn, bf16* WT, LAS float* scr, int item, int lane, const SrcFn& src) {
    const int kb = item / nblk, nb = item % nblk, k0 = 64 * kb, n0 = 32 * nb;
    if (VEC) {
        const float* colp = src(n0 + 4 * (lane & 7)) + (size_t)(k0 + (lane >> 3)) * ldn;
        f32x4 v[8];
#pragma unroll
        for (int i = 0; i < 8; ++i) v[i] = *(const f32x4*)(colp + (size_t)(8 * i) * ldn);
#pragma unroll
        for (int i = 0; i < 8; ++i) { LAS float* d = scr + (8 * i + (lane >> 3)) * 33 + 4 * (lane & 7); d[0] = v[i].x; d[1] = v[i].y; d[2] = v[i].z; d[3] = v[i].w; }
    } else {
        const float* colp = src(n0 + (lane & 31));
#pragma unroll 8
        for (int i = 0; i < 32; ++i) { const int kk = 2 * i + (lane >> 5); scr[kk * 33 + (lane & 31)] = colp[(size_t)(k0 + kk) * ldn]; }
    }
    LDS_WAIT(); asm volatile("" ::: "memory");
    const int c = lane & 7;
#pragma unroll
    for (int j = 0; j < 4; ++j) { const int n = (lane >> 3) + 8 * j; const LAS float* s = scr + (8 * c) * 33 + n;
        v4u o; o.x = pk2(s[0 * 33], s[1 * 33]); o.y = pk2(s[2 * 33], s[3 * 33]); o.z = pk2(s[4 * 33], s[5 * 33]); o.w = pk2(s[6 * 33], s[7 * 33]);
        *(GAS v4u*)(WT + (size_t)(n0 + n) * K + k0 + 8 * c) = o; }
    LDS_WAIT(); asm volatile("" ::: "memory");
}
template <class SrcFn>
__device__ __forceinline__ void p0_item8(int K, int nblk, size_t ldn, unsigned char* WT, LAS float* scr, int item, int lane, float scale, const SrcFn& src) {
    const int kb = item / nblk, nb = item % nblk, k0 = 64 * kb, n0 = 32 * nb;
    { const float* colp = src(n0 + 4 * (lane & 7)) + (size_t)(k0 + (lane >> 3)) * ldn;
      f32x4 v[8];
#pragma unroll
      for (int i = 0; i < 8; ++i) v[i] = *(const f32x4*)(colp + (size_t)(8 * i) * ldn);
#pragma unroll
      for (int i = 0; i < 8; ++i) { LAS float* d = scr + (8 * i + (lane >> 3)) * 33 + 4 * (lane & 7); d[0] = v[i].x * scale; d[1] = v[i].y * scale; d[2] = v[i].z * scale; d[3] = v[i].w * scale; } }
    LDS_WAIT(); asm volatile("" ::: "memory");
    const int c = lane & 3;
#pragma unroll
    for (int j = 0; j < 2; ++j) { const int n = (lane >> 2) + 16 * j; const LAS float* s = scr + (16 * c) * 33 + n;
        v4u o; o.x = pg8::pk4_fp8(s[0 * 33], s[1 * 33], s[2 * 33], s[3 * 33]); o.y = pg8::pk4_fp8(s[4 * 33], s[5 * 33], s[6 * 33], s[7 * 33]);
        o.z = pg8::pk4_fp8(s[8 * 33], s[9 * 33], s[10 * 33], s[11 * 33]); o.w = pg8::pk4_fp8(s[12 * 33], s[13 * 33], s[14 * 33], s[15 * 33]);
        *(GAS v4u*)(WT + (size_t)(n0 + n) * K + k0 + 16 * c) = o; }
    LDS_WAIT(); asm volatile("" ::: "memory");
}
__device__ __forceinline__ void p0_prologue(Frame& F) {
    LANE_DECL;
    LAS float* scr = (LAS float*)(F.lds + RING_OFF + wave * 16384);
    const int gw = F.vcu * NWAVES + wave, NGW = F.G * NWAVES;
    unsigned char* ws = F.ws;
    constexpr int I_IN = (DM / 64) * (INW / 32), I_OUT = (DM / 64) * (DM / 32), I_GU = (DM / 64) * (2 * FFD / 32), I_D = (FFD / 64) * (DM / 32);
    constexpr int I_MGU = (DM / 64) * (2 * EDIM / 32), I_MD = (EDIM / 64) * (DM / 32);
    constexpr int NITEMS = 2 * I_IN + 2 * I_OUT + I_GU + I_D + NEXP * I_MGU + NEXP * I_MD;
    for (int it = gw; it < NITEMS; it += NGW) {
        int r = it;
        if (r < 2 * I_IN) { const int l = r / I_IN; r -= l * I_IN; const float* W = inp(2) + (size_t)l * DM * INW;
            const int nb = r % (INW / 32);
            if (nb >= PC_POOL / 32 && nb < PC_RQ / 32) continue;
            if (nb >= PC_RQ / 32 && nb < PC_RV / 32)
                p0_item<false>(DM, INW / 32, INW, (bf16*)(ws + WS_WIN) + (size_t)l * INW * DM, scr, r, lane, [&](int n) -> const float* { const int p = (n - PC_RQ) & 63; return W + (n - p) + (p >> 1) + 32 * (p & 1); });
            else
                p0_item<true>(DM, INW / 32, INW, (bf16*)(ws + WS_WIN) + (size_t)l * INW * DM, scr, r, lane, [&](int n) -> const float* { return W + n; });
            continue; }
        r -= 2 * I_IN;
        if (r < 2 * I_OUT) { const int l = r / I_OUT; r -= l * I_OUT; const float* W = inp(8) + (size_t)l * DM * DM;
            p0_item<true>(DM, DM / 32, DM, (bf16*)(ws + WS_WOUT) + (size_t)l * DM * DM, scr, r, lane, [&](int n) -> const float* { return W + n; }); continue; }
        r -= 2 * I_OUT;
        if (r < I_GU) { const float* Wg = inp(13); const float* Wu = inp(14);
            p0_item<true>(DM, 2 * FFD / 32, FFD, (bf16*)(ws + WS_WGU), scr, r, lane, [&](int n) -> const float* { const int pn = n >> 8, hb = (n >> 7) & 1, j = n & 127; return (hb ? Wu : Wg) + pn * 128 + j; }); continue; }
        r -= I_GU;
        if (r < I_D) { const float* W = inp(15);
            p0_item<true>(FFD, DM / 32, DM, (bf16*)(ws + WS_WD), scr, r, lane, [&](int n) -> const float* { return W + n; }); continue; }
        r -= I_D;
        if (r < NEXP * I_MGU) { const int e = r / I_MGU; r -= e * I_MGU; const float* Wg = inp(17) + (size_t)e * DM * EDIM; const float* Wu = inp(18) + (size_t)e * DM * EDIM;
            p0_item8(DM, 2 * EDIM / 32, EDIM, (unsigned char*)(ws + WS_MGU) + (size_t)e * 2 * EDIM * DM, scr, r, lane, pg8::F8_SU, [&](int n) -> const float* { const int pn = n >> 8, hb = (n >> 7) & 1, j = n & 127; return (hb ? Wu : Wg) + pn * 128 + j; }); continue; }
        r -= NEXP * I_MGU;
        { const int e = r / I_MD; r -= e * I_MD; const float* W = inp(19) + (size_t)e * EDIM * DM;
            p0_item8(EDIM, DM / 32, DM, (unsigned char*)(ws + WS_MD) + (size_t)e * DM * EDIM, scr, r, lane, pg8::F8_SD, [&](int n) -> const float* { return W + n; }); }
    }
    const int gt = F.vcu * NTHR + tid, NT = F.G * NTHR;
    for (int o = gt; o < DEPTH * 4 * DM * 16; o += NT) {
        const int l = o >> 16, g = (o >> 14) & 3, k = (o >> 4) & (DM - 1), d4 = o & 15;
        const float* wr = inp(2) + (size_t)l * DM * INW + (size_t)k * INW + PC_POOL + g * 64;
        const float* pw = inp(5) + (size_t)l * 4 * 64 * 64 + (size_t)g * 64 * 64 + 4 * d4;
        f32x4 acc = {0.f, 0.f, 0.f, 0.f};
#pragma unroll 4
        for (int c4 = 0; c4 < 16; ++c4) { const f32x4 w4 = *(const f32x4*)(wr + 4 * c4);
            acc = acc + *(const f32x4*)(pw + (4 * c4 + 0) * 64) * w4.x + *(const f32x4*)(pw + (4 * c4 + 1) * 64) * w4.y + *(const f32x4*)(pw + (4 * c4 + 2) * 64) * w4.z + *(const f32x4*)(pw + (4 * c4 + 3) * 64) * w4.w; }
        bf16* dst = (bf16*)(ws + WS_WIN) + (size_t)l * INW * DM + (size_t)(PC_POOL + g * 64 + 4 * d4) * DM + k;
        dst[0] = (bf16)f2bf(acc.x); dst[(size_t)DM] = (bf16)f2bf(acc.y); dst[(size_t)2 * DM] = (bf16)f2bf(acc.z); dst[(size_t)3 * DM] = (bf16)f2bf(acc.w);
    }
    { const GAS f32x4* x4 = (const GAS f32x4*)inp(0); GAS v4u* xb = (GAS v4u*)(ws + WS_XB);
      for (int i = gt; i < MROWS * DM / 8; i += 4 * NT) { f32x4 a[4], b[4];
#pragma unroll
          for (int u = 0; u < 4; ++u) { a[u] = x4[2 * (i + u * NT)]; b[u] = x4[2 * (i + u * NT) + 1]; }
#pragma unroll
          for (int u = 0; u < 4; ++u) { v4u o; o.x = pk2(a[u].x, a[u].y); o.y = pk2(a[u].z, a[u].w); o.z = pk2(b[u].x, b[u].y); o.w = pk2(b[u].z, b[u].w); xb[i + u * NT] = o; } } }
}

__device__ __forceinline__ int ln_elem(int lane, int jj) { return (jj >> 1) * 512 + 8 * lane + (jj & 1) * 4; }
__device__ __forceinline__ void ln_unpack(f32x4 (&v)[4], v4u w0, v4u w1) {
    v[0] = (f32x4){bflo(w0.x), bfhi(w0.x), bflo(w0.y), bfhi(w0.y)}; v[1] = (f32x4){bflo(w0.z), bfhi(w0.z), bflo(w0.w), bfhi(w0.w)};
    v[2] = (f32x4){bflo(w1.x), bfhi(w1.x), bflo(w1.y), bfhi(w1.y)}; v[3] = (f32x4){bflo(w1.z), bfhi(w1.z), bflo(w1.w), bfhi(w1.w)};
}
__device__ __forceinline__ void ln_stats(f32x4 (&v)[4], float& mean, float& rstd) {
    float s = 0.f;
#pragma unroll
    for (int j = 0; j < 4; ++j) s += (v[j].x + v[j].y) + (v[j].z + v[j].w);
    mean = wave_sum(s) * (1.f / DM); float s2 = 0.f;
#pragma unroll
    for (int j = 0; j < 4; ++j) { v[j] = v[j] - mean; s2 += (v[j].x * v[j].x + v[j].y * v[j].y) + (v[j].z * v[j].z + v[j].w * v[j].w); }
    rstd = 1.f / sqrtf(wave_sum(s2) * (1.f / DM) + LN_EPS);
}
struct LnGains { f32x4 g[4], b[4]; };
__device__ __forceinline__ void ln_load_gains(LnGains& G, const float* g, const float* b, int lane) {
#pragma unroll
    for (int j = 0; j < 4; ++j) { G.g[j] = *(const f32x4*)(g + ln_elem(lane, j)); G.b[j] = *(const f32x4*)(b + ln_elem(lane, j)); }
}
__device__ __forceinline__ void ln_affine(f32x4 (&v)[4], float rstd, const LnGains& G) {
#pragma unroll
    for (int j = 0; j < 4; ++j) v[j] = v[j] * rstd * G.g[j] + G.b[j];
}
__device__ __forceinline__ void store_row_bf16(const f32x4 (&v)[4], bf16* orow, int lane) {
    GAS v4u* o = (GAS v4u*)orow + lane;
    v4u a, c; a.x = pk2(v[0].x, v[0].y); a.y = pk2(v[0].z, v[0].w); a.z = pk2(v[1].x, v[1].y); a.w = pk2(v[1].z, v[1].w);
    c.x = pk2(v[2].x, v[2].y); c.y = pk2(v[2].z, v[2].w); c.z = pk2(v[3].x, v[3].y); c.w = pk2(v[3].z, v[3].w);
    o[0] = a; o[64] = c;
}

template <bool ROUTER>
__device__ __forceinline__ void ln1_phase(Frame& F, int l) {
    LANE_DECL;
    const bf16* T = (const bf16*)F.out; bf16* X1 = (bf16*)(F.ws + WS_O);
    LnGains G; ln_load_gains(G, inp(9) + l * DM, inp(10) + l * DM, lane);
    LAS int* hist = (LAS int*)(F.lds + RING_OFF);
    f32x4 rw[ROUTER ? 16 : 1][2];
    if (ROUTER) { const float* rwp = inp(16);
#pragma unroll
        for (int j = 0; j < 4; ++j)
#pragma unroll
            for (int q = 0; q < 4; ++q) { const int k = ln_elem(lane, j) + q; rw[(4 * j + q) * (ROUTER ? 1 : 0)][0] = *(const f32x4*)(rwp + k * 8); rw[(4 * j + q) * (ROUTER ? 1 : 0)][1] = *(const f32x4*)(rwp + k * 8 + 4); } }
    for (int blk = F.vcu; blk < MROWS / 256; blk += F.G) {
        if (ROUTER) { if (tid < 8) hist[tid] = 0; __syncthreads(); }
        for (int i = 0; i < 32; i += 4) {
            const int row = blk * 256 + wave * 32 + i;
            v4u w0[4], w1[4];
#pragma unroll
            for (int rr = 0; rr < 4; ++rr) { const GAS v4u* tr = (const GAS v4u*)(T + (size_t)(row + rr) * DM) + lane; w0[rr] = tr[0]; w1[rr] = tr[64]; }
#pragma unroll
            for (int rr = 0; rr < 4; ++rr) {
                f32x4 v[4]; ln_unpack(v, w0[rr], w1[rr]);
                float mean, rstd; ln_stats(v, mean, rstd); ln_affine(v, rstd, G);
                store_row_bf16(v, X1 + (size_t)(row + rr) * DM, lane);
                if (ROUTER) {
                    float lg[8];
#pragma unroll
                    for (int e = 0; e < 8; ++e) lg[e] = 0.f;
#pragma unroll
                    for (int j = 0; j < 4; ++j)
#pragma unroll
                        for (int q = 0; q < 4; ++q) { const f32x4 r0 = rw[(4 * j + q) * (ROUTER ? 1 : 0)][0], r1 = rw[(4 * j + q) * (ROUTER ? 1 : 0)][1]; const float xv = v[j][q];
                            lg[0] += xv * r0.x; lg[1] += xv * r0.y; lg[2] += xv * r0.z; lg[3] += xv * r0.w; lg[4] += xv * r1.x; lg[5] += xv * r1.y; lg[6] += xv * r1.z; lg[7] += xv * r1.w; }
                    float h4[4], h2[2], h1;
                    { const bool up = (lane & 32) != 0;
#pragma unroll
                      for (int e = 0; e < 4; ++e) { const float snd = up ? lg[e] : lg[e + 4], kp = up ? lg[e + 4] : lg[e]; h4[e] = kp + __shfl_xor(snd, 32); } }
                    { const bool up = (lane & 16) != 0;
#pragma unroll
                      for (int e = 0; e < 2; ++e) { const float snd = up ? h4[e] : h4[e + 2], kp = up ? h4[e + 2] : h4[e]; h2[e] = kp + __shfl_xor(snd, 16); } }
                    { const bool up = (lane & 8) != 0; const float snd = up ? h2[0] : h2[1], kp = up ? h2[1] : h2[0]; h1 = kp + __shfl_xor(snd, 8); }
                    h1 += __shfl_xor(h1, 4); h1 += __shfl_xor(h1, 2); h1 += __shfl_xor(h1, 1);
                    float ls[8];
#pragma unroll
                    for (int e = 0; e < 8; ++e) ls[e] = __int_as_float(__builtin_amdgcn_readlane(__float_as_int(h1), ((e >> 2) & 1) * 32 + ((e >> 1) & 1) * 16 + (e & 1) * 8));
                    int e1 = 0; float v1 = ls[0];
#pragma unroll
                    for (int e = 1; e < 8; ++e) if (ls[e] > v1) { v1 = ls[e]; e1 = e; }
                    int e2 = -1; float v2 = -INFINITY;
#pragma unroll
                    for (int e = 0; e < 8; ++e) if (e != e1 && ls[e] > v2) { v2 = ls[e]; e2 = e; }
                    const float g1 = 1.f / (1.f + __expf(v2 - v1)), g2 = 1.f - g1;
                    if (lane == 0) {
                        int* re = (int*)(F.ws + WS_RE); float* rg = (float*)(F.ws + WS_RG);
                        re[2 * (row + rr)] = e1; re[2 * (row + rr) + 1] = e2; rg[2 * (row + rr)] = g1; rg[2 * (row + rr) + 1] = g2;
                        atomicAdd((int*)&hist[e1], 1); atomicAdd((int*)&hist[e2], 1);
                    }
                }
            }
        }
        if (ROUTER) { __syncthreads(); if (tid < 8) ((int*)(F.ws + WS_BC))[blk * 8 + tid] = hist[tid]; __syncthreads(); }
    }
}
__device__ __forceinline__ void ln2_phase(Frame& F, int l) {
    LANE_DECL;
    const bf16* T = (const bf16*)F.out; bf16* XB = (bf16*)(F.ws + WS_XB);
    LnGains G; ln_load_gains(G, inp(11) + l * DM, inp(12) + l * DM, lane);
    const int gw = F.vcu * NWAVES + wave, NGW = F.G * NWAVES;
    for (int r4 = gw; r4 < MROWS / 4; r4 += NGW) {
        const int row = 4 * r4;
        v4u w0[4], w1[4];
#pragma unroll
        for (int rr = 0; rr < 4; ++rr) { const GAS v4u* tr = (const GAS v4u*)(T + (size_t)(row + rr) * DM) + lane; w0[rr] = tr[0]; w1[rr] = tr[64]; }
#pragma unroll
        for (int rr = 0; rr < 4; ++rr) { f32x4 v[4]; ln_unpack(v, w0[rr], w1[rr]);
            float mean, rstd; ln_stats(v, mean, rstd); ln_affine(v, rstd, G);
            store_row_bf16(v, XB + (size_t)(row + rr) * DM, lane); }
    }
}

__device__ __forceinline__ void route_phase(Frame& F) {
    LANE_DECL;
    LAS int* cnts = (LAS int*)(F.lds + RING_OFF);
    LAS int* tot = cnts + 2048; LAS int* offp = tot + 8; LAS int* base = offp + 8; LAS int* wcnt = base + 8; LAS int* ntl = wcnt + 64;
    const int* bc = (const int*)(F.ws + WS_BC); const int* re = (const int*)(F.ws + WS_RE);
    int* rs = (int*)(F.ws + WS_RS); int* mi = (int*)(F.ws + WS_MI);
    const bf16* X1 = (const bf16*)(F.ws + WS_O); unsigned char* XG8 = F.ws + WS_XG8;
    for (int blk = F.vcu; blk < MROWS / 256; blk += F.G) {
        __syncthreads();
        for (int i = tid; i < 2048; i += NTHR) cnts[i] = bc[i];
        __syncthreads();
        if (tid < 8) { int run = 0, mine = 0; for (int w = 0; w < 256; ++w) { if (w == blk) mine = run; run += cnts[w * 8 + tid]; } tot[tid] = run; base[tid] = mine; }
        __syncthreads();
        if (tid == 0) { int off = 0; for (int e = 0; e < 8; ++e) { offp[e] = off; off += (tot[e] + 255) & ~255; } ntl[0] = off >> 8; }
        __syncthreads();
        const int a = tid, tok = blk * 256 + (a >> 1), k = a & 1;
        const int e = re[2 * tok + k];
        int rk = 0;
#pragma unroll
        for (int ee = 0; ee < 8; ++ee) { const unsigned long long mask = __ballot(e == ee); if (e == ee) rk = __popcll(mask & ((1ull << lane) - 1ull)); if (lane == 0) wcnt[wave * 8 + ee] = __popcll(mask); }
        __syncthreads();
        int wb = 0;
        for (int w = 0; w < wave; ++w) wb += wcnt[w * 8 + e];
        const int slot = offp[e] + base[e] + wb + rk;
        rs[2 * tok + k] = slot;
        for (int i = 0; i < 64; i += 4) { const int s0 = __shfl(slot, i), s1 = __shfl(slot, i + 1), s2 = __shfl(slot, i + 2), s3 = __shfl(slot, i + 3), ta = __shfl(tok, i), tb = __shfl(tok, i + 2);
            const GAS v4u* srca = (const GAS v4u*)(X1 + (size_t)ta * DM) + 2 * lane; const GAS v4u* srcb = (const GAS v4u*)(X1 + (size_t)tb * DM) + 2 * lane;
            const v4u a0 = srca[0], a1 = srca[1], b0 = srcb[0], b1 = srcb[1];
            v4u oa, ob; const float sx = pg8::F8_SX;
            oa.x = pg8::pk4_fp8(sx * bflo(a0.x), sx * bfhi(a0.x), sx * bflo(a0.y), sx * bfhi(a0.y)); oa.y = pg8::pk4_fp8(sx * bflo(a0.z), sx * bfhi(a0.z), sx * bflo(a0.w), sx * bfhi(a0.w));
            oa.z = pg8::pk4_fp8(sx * bflo(a1.x), sx * bfhi(a1.x), sx * bflo(a1.y), sx * bfhi(a1.y)); oa.w = pg8::pk4_fp8(sx * bflo(a1.z), sx * bfhi(a1.z), sx * bflo(a1.w), sx * bfhi(a1.w));
            ob.x = pg8::pk4_fp8(sx * bflo(b0.x), sx * bfhi(b0.x), sx * bflo(b0.y), sx * bfhi(b0.y)); ob.y = pg8::pk4_fp8(sx * bflo(b0.z), sx * bfhi(b0.z), sx * bflo(b0.w), sx * bfhi(b0.w));
            ob.z = pg8::pk4_fp8(sx * bflo(b1.x), sx * bfhi(b1.x), sx * bflo(b1.y), sx * bfhi(b1.y)); ob.w = pg8::pk4_fp8(sx * bflo(b1.z), sx * bfhi(b1.z), sx * bflo(b1.w), sx * bfhi(b1.w));
            *((GAS v4u*)(XG8 + (size_t)s0 * DM) + lane) = oa; *((GAS v4u*)(XG8 + (size_t)s1 * DM) + lane) = oa; *((GAS v4u*)(XG8 + (size_t)s2 * DM) + lane) = ob; *((GAS v4u*)(XG8 + (size_t)s3 * DM) + lane) = ob; }
        for (int ee = 0; ee < 8; ++ee) { const int lo = offp[ee] + tot[ee], hi = offp[ee] + ((tot[ee] + 255) & ~255);
            for (int s = lo + blk; s < hi; s += MROWS / 256) { if (tid < 256) ((GAS unsigned*)(XG8 + (size_t)s * DM))[tid] = 0u; } }
        if (blk == 0) { const int ntiles = ntl[0];
            if (tid == 0) mi[0] = ntiles;
            for (int t = tid; t < ntiles; t += NTHR) { int ee = 0;
#pragma unroll
                for (int x = 1; x < 8; ++x) if (t * 256 >= offp[x]) ee = x;
                mi[16 + t] = ee; } }
    }
}

__device__ __forceinline__ void f8_unpack(f32x4 (&v)[4], unsigned long long w0, unsigned long long w1, float s) {
    typedef float f2_ __attribute__((ext_vector_type(2)));
    const int a = (int)(unsigned)w0, b = (int)(unsigned)(w0 >> 32), c = (int)(unsigned)w1, d = (int)(unsigned)(w1 >> 32);
    const f2_ a0 = __builtin_amdgcn_cvt_pk_f32_fp8(a, false), a1 = __builtin_amdgcn_cvt_pk_f32_fp8(a, true), b0 = __builtin_amdgcn_cvt_pk_f32_fp8(b, false), b1 = __builtin_amdgcn_cvt_pk_f32_fp8(b, true);
    const f2_ c0 = __builtin_amdgcn_cvt_pk_f32_fp8(c, false), c1 = __builtin_amdgcn_cvt_pk_f32_fp8(c, true), d0 = __builtin_amdgcn_cvt_pk_f32_fp8(d, false), d1 = __builtin_amdgcn_cvt_pk_f32_fp8(d, true);
    v[0] = (f32x4){a0.x, a0.y, a1.x, a1.y} * s; v[1] = (f32x4){b0.x, b0.y, b1.x, b1.y} * s; v[2] = (f32x4){c0.x, c0.y, c1.x, c1.y} * s; v[3] = (f32x4){d0.x, d0.y, d1.x, d1.y} * s;
}
__device__ __forceinline__ void moe_out_phase(Frame& F, int l) {
    LANE_DECL;
    const bf16* X1 = (const bf16*)(F.ws + WS_O); const unsigned char* YB = F.ws + WS_XG;
    const int* rs = (const int*)(F.ws + WS_RS); const float* rg = (const float*)(F.ws + WS_RG);
    LnGains G; ln_load_gains(G, inp(11) + l * DM, inp(12) + l * DM, lane);
    const int gw = F.vcu * NWAVES + wave, NGW = F.G * NWAVES;
    constexpr float IY = 1.0f / pg8::F8_SY;
    for (int rp = gw; rp < MROWS / 4; rp += NGW) {
        const int row = 4 * rp;
        const v4u sa = *(const v4u*)(rs + 2 * row), sb = *(const v4u*)(rs + 2 * row + 4); const f32x4 ga = *(const f32x4*)(rg + 2 * row), gb = *(const f32x4*)(rg + 2 * row + 4);
        const int s1[4] = {(int)sa.x, (int)sa.z, (int)sb.x, (int)sb.z}, s2[4] = {(int)sa.y, (int)sa.w, (int)sb.y, (int)sb.w}; const float g1[4] = {ga.x * IY, ga.z * IY, gb.x * IY, gb.z * IY}, g2[4] = {ga.y * IY, ga.w * IY, gb.y * IY, gb.w * IY};
        v4u xa[4][2]; unsigned long long pa[4][2], qa[4][2];
#pragma unroll
        for (int rr = 0; rr < 4; ++rr) {
            const GAS v4u* xr = (const GAS v4u*)(X1 + (size_t)(row + rr) * DM) + lane;
            const GAS unsigned long long* y1 = (const GAS unsigned long long*)(YB + (size_t)s1[rr] * DM) + lane;
            const GAS unsigned long long* y2 = (const GAS unsigned long long*)(YB + (size_t)s2[rr] * DM) + lane;
            xa[rr][0] = xr[0]; xa[rr][1] = xr[64]; pa[rr][0] = y1[0]; pa[rr][1] = y1[64]; qa[rr][0] = y2[0]; qa[rr][1] = y2[64]; }
#pragma unroll
        for (int rr = 0; rr < 4; ++rr) {
            f32x4 v[4], p[4], q[4]; ln_unpack(v, xa[rr][0], xa[rr][1]); f8_unpack(p, pa[rr][0], pa[rr][1], g1[rr]); f8_unpack(q, qa[rr][0], qa[rr][1], g2[rr]);
#pragma unroll
            for (int j = 0; j < 4; ++j) v[j] = v[j] * ALPHA + (p[j] + q[j]);
            float mean, rstd; ln_stats(v, mean, rstd); ln_affine(v, rstd, G);
            GAS f32x4* o = (GAS f32x4*)(F.out + (size_t)(row + rr) * DM) + 2 * lane;
            o[0] = v[0]; o[1] = v[1]; o[128] = v[2]; o[129] = v[3];
        }
    }
}

__device__ __forceinline__ float lam_init_of(int l) { return l == 0 ? 0.2f : 0.35550906759096934f; }
__device__ __forceinline__ float lambda_of(int l, int lane) {
    const float* dl = inp(3) + l * 256; const int ln = lane;
    const float a = wave_sum(dl[ln] * dl[64 + ln]), b = wave_sum(dl[128 + ln] * dl[192 + ln]);
    return __expf(a) - __expf(b) + lam_init_of(l);
}
__device__ __forceinline__ void combine_phase(Frame& F, int l) {
    LANE_DECL;
    const bf16* P = (const bf16*)(F.ws + WS_P); bf16* Y = (bf16*)(F.ws + WS_Y);
    const float* psc = inp(6) + l * 256;
    const f32x4 ps = *(const f32x4*)(psc + 4 * lane);
    const int grp = lane >> 4, win = 2 << grp;
    for (;;) {
        int rb = 0; if (lane == 0) rb = (int)__hip_atomic_fetch_add((unsigned*)(F.ctl + CW_PLQ) + l * 64, 1u, __ATOMIC_RELAXED, __HIP_MEMORY_SCOPE_AGENT);
        rb = __builtin_amdgcn_readfirstlane(rb); if (rb >= MROWS / 32) break;
        const int row0 = rb * 32, t0 = row0 & (SEQ - 1);
        f32x4 acc = {0.f, 0.f, 0.f, 0.f};
        for (int j = 1; j <= 16; ++j) { if (j <= win && t0 - j >= 0) { const unsigned long long w = *((const GAS unsigned long long*)(P + (size_t)(row0 - j) * INW + PC_POOL) + lane);
                acc = acc + (f32x4){bflo((unsigned)w), bfhi((unsigned)w), bflo((unsigned)(w >> 32)), bfhi((unsigned)(w >> 32))}; } }
        for (int i0 = 0; i0 < 32; i0 += 8) {
            unsigned long long pc[8], po[8];
#pragma unroll
            for (int u = 0; u < 8; ++u) { const int row = row0 + i0 + u, t = t0 + i0 + u;
                pc[u] = *((const GAS unsigned long long*)(P + (size_t)row * INW + PC_POOL) + lane);
                const int ro = (t - win >= 0) ? row - win : row;
                po[u] = *((const GAS unsigned long long*)(P + (size_t)ro * INW + PC_POOL) + lane); }
#pragma unroll
            for (int u = 0; u < 8; ++u) { const int row = row0 + i0 + u, t = t0 + i0 + u;
                const f32x4 cur = {bflo((unsigned)pc[u]), bfhi((unsigned)pc[u]), bflo((unsigned)(pc[u] >> 32)), bfhi((unsigned)(pc[u] >> 32))};
                const f32x4 old = {bflo((unsigned)po[u]), bfhi((unsigned)po[u]), bflo((unsigned)(po[u] >> 32)), bfhi((unsigned)(po[u] >> 32))};
                acc = acc + cur; if (t - win >= 0) acc = acc - old;
                const int cnt = (t + 1 < win) ? t + 1 : win; const float ic = 1.0f / (float)cnt;
                const f32x4 po4 = (acc * ic - cur) * ps;
                *((GAS unsigned long long*)(Y + (size_t)row * DM + 512) + lane) = (unsigned long long)pk2(po4.x, po4.y) | ((unsigned long long)pk2(po4.z, po4.w) << 32);
            }
        }
    }
}

__device__ __forceinline__ int t5_bucket(int n) {
    if (n < 16) return n;
    const float v = (__log2f((float)n) - 4.0f) * (16.0f / 3.0f);
    const int b = 16 + (int)v; return b < 31 ? b : 31;
}
struct AttnAux {
    static constexpr long O0_OFF = ((long)WS_O - (long)WS_Y) / 2;
    static __device__ __forceinline__ float lam(int l, int lane) { return __int_as_float(__builtin_amdgcn_readfirstlane(__float_as_int(lambda_of(l, lane)))); }
    static __device__ __forceinline__ float post(int l) { return 1.0f - lam_init_of(l); }
    static __device__ __forceinline__ const float* sg(int l) { return inp(4) + l * 128; }
};
__device__ __forceinline__ void mixers_phase(Frame& F, int l, char* lds_generic) {
    ret::ret_kv_units(F.lds + RING_OFF, (const unsigned short*)(F.ws + WS_P), (float*)(F.ws + WS_AT), F.vcu, F.G, BATCH * 4 * (SEQ / 128));
    asm volatile("s_waitcnt vmcnt(0)" ::: "memory"); __syncthreads();
    if (threadIdx.x == 0) { __builtin_amdgcn_fence(__ATOMIC_RELEASE, "agent"); asm volatile("s_waitcnt vmcnt(0)" ::: "memory"); __hip_atomic_fetch_add((unsigned*)(F.ctl + CW_R1) + l * 64, 1u, __ATOMIC_RELAXED, __HIP_MEMORY_SCOPE_AGENT); }
    __syncthreads();
    attn_body::attn_phase_w<8, AttnAux>(lds_generic + RING_OFF, (const attn_body::bf16*)(F.ws + WS_P), (attn_body::bf16*)(F.ws + WS_O), (attn_body::bf16*)(F.ws + WS_Y), inp(1), F.vcu, l, (unsigned*)(F.ctl + CW_ATQ) + l * 32 * 32, F.MISC + 20);
}
__device__ __forceinline__ void ret_out_phase(Frame& F, int l) {
    if (threadIdx.x == 0) { unsigned sp = 0; while (__hip_atomic_load((unsigned*)(F.ctl + CW_R1) + l * 64, __ATOMIC_RELAXED, __HIP_MEMORY_SCOPE_AGENT) < (unsigned)F.G) { __builtin_amdgcn_s_sleep(2); if (++sp > (1u << 24)) break; } }
    __syncthreads();
    for (;;) {
        if (threadIdx.x == 0) F.MISC[20] = __hip_atomic_fetch_add((unsigned*)(F.ctl + CW_R3Q) + l * 64, 1u, __ATOMIC_RELAXED, __HIP_MEMORY_SCOPE_AGENT);
        __syncthreads(); const int u = (int)__builtin_amdgcn_readfirstlane((int)F.MISC[20]); __syncthreads();
        if (u >= BATCH * 4 * 8) break;
        ret::ret_out_unit(F.lds + RING_OFF, (const unsigned short*)(F.ws + WS_P), (unsigned short*)(F.ws + WS_Y), (const float*)(F.ws + WS_AT), inp(7) + l * 256, ((u & 31) << 3) | (7 - (u >> 5)));
    }
}

#ifndef MK_ONE_LAUNCH
#define MK_ONE_LAUNCH 1
#endif
constexpr int N_PHASES = 26;
__device__ __forceinline__ int cta_id() { int c = blockIdx.x; asm volatile("" : "+s"(c)); return c; }
struct Args { const float* in[20]; float* out; unsigned char* ws; int ph_lo, ph_hi; };
__global__ void __launch_bounds__(NTHR, 2) hymba_fwd(Args args) {
    extern __shared__ __attribute__((aligned(16))) unsigned char lds[];
    Frame F;
    F.lds = (LAS unsigned char*)lds;
    F.MISC = (volatile LAS unsigned*)(F.lds + MISC_OFF);
    F.G = gridDim.x; { const int bx = blockIdx.x; F.vcu = (F.G % 8 == 0) ? (bx % 8) * (F.G / 8) + bx / 8 : bx; }
    F.ws = args.ws; F.out = args.out; F.ctl = (gu32*)(args.ws + WS_CTL);
    for (int u = threadIdx.x; u < (LDS_BYTES - LDSCTL_OFF) / 4; u += NTHR) ((LAS unsigned*)(F.lds + LDSCTL_OFF))[u] = 0u;
    __syncthreads();
#if MK_ONE_LAUNCH
    XcdBarrier bar = xcd_barrier_post((unsigned*)(F.ctl + CW_BAR), F.MISC + 8);
#define GRID_BAR() xcd_barrier(bar)
#else
#define GRID_BAR() do {} while (0)
#endif
    const int lo = args.ph_lo, hi = args.ph_hi;
#ifndef PHASE_OK
#define PHASE_OK(k) true
#endif
#define IN(k) (PHASE_OK(k) && lo <= (k) && (k) < hi)
#define SEAM(k) do { if (IN((k) + 1)) GRID_BAR(); } while (0)
#ifndef REPEAT_OK
#define REPEAT_OK(k) false
#endif
#define RUN(k, ...) do { if (IN(k)) { __VA_ARGS__ if (REPEAT_OK(k)) { GRID_BAR(); __VA_ARGS__ } SEAM(k); } } while (0)
    unsigned char* ws = args.ws;
    bf16* XB = (bf16*)(ws + WS_XB); bf16* Y = (bf16*)(ws + WS_Y); bf16* P = (bf16*)(ws + WS_P); bf16* X1 = (bf16*)(ws + WS_O);

    RUN(0, p0_prologue(F););

    for (int l = 0; l < DEPTH; ++l) {
        const int pb = 1 + 8 * l;
        RUN(pb + 0,
            pg8::Gemm g{XB, (const bf16*)(ws + WS_WIN) + (size_t)l * INW * DM, MROWS, INW, DM, 0};
            pg8::GOrder S; S.init(MROWS / 256, INW, F.G, cta_id(), 0, 0, nullptr);
            pg8::EpiInProj E{P};
            pg8::gemm_phase<pg8::EpiInProj, pg8::GOrder, true, true>(F.lds + RING_OFF, g, S, E);
            );
        if (IN(pb + 1)) { mixers_phase(F, l, (char*)lds); if (IN(pb + 2)) __syncthreads(); }
        RUN(pb + 2, ret_out_phase(F, l); combine_phase(F, l););
        RUN(pb + 3,
            pg8::Gemm g{Y, (const bf16*)(ws + WS_WOUT) + (size_t)l * DM * DM, MROWS, DM, DM, 0};
            pg8::GOrder S; S.init(MROWS / 256, DM, F.G, cta_id(), 0, 0, nullptr);
            pg8::EpiResid E{XB, (bf16*)F.out, ALPHA};
            pg8::gemm_phase<pg8::EpiResid, pg8::GOrder, true, true>(F.lds + RING_OFF, g, S, E);
            );
        if (l == 0) {
            RUN(5, ln1_phase<false>(F, l););
            RUN(6,
                pg8::Gemm g{X1, (const bf16*)(ws + WS_WGU), MROWS, 2 * FFD, DM, 0};
                pg8::GOrder S; S.init(MROWS / 256, 2 * FFD, F.G, cta_id(), 0, 0, nullptr);
                pg8::EpiSwiGLU E{P, FFD};
                pg8::gemm_phase<pg8::EpiSwiGLU, pg8::GOrder, true, true>(F.lds + RING_OFF, g, S, E);
                );
            RUN(7,
                pg8::Gemm g{P, (const bf16*)(ws + WS_WD), MROWS, DM, FFD, 0};
                pg8::GOrder S; S.init(MROWS / 256, DM, F.G, cta_id(), 0, 0, nullptr);
                pg8::EpiResid E{X1, (bf16*)F.out, ALPHA};
                pg8::gemm_phase<pg8::EpiResid, pg8::GOrder, true, true>(F.lds + RING_OFF, g, S, E);
                );
            RUN(8, ln2_phase(F, l););
        } else {
            RUN(13, ln1_phase<true>(F, l););
            RUN(14, route_phase(F););
            if (IN(15) || IN(16) || IN(17) || IN(18)) {
                const int* mi = (const int*)(ws + WS_MI);
                const int ntiles = (int)__builtin_amdgcn_readfirstlane((int)__hip_atomic_load(mi, __ATOMIC_RELAXED, __HIP_MEMORY_SCOPE_AGENT));
                LAS int* lds_te = (LAS int*)(F.lds + LDSTE_OFF);
                __syncthreads(); { int ti_ = threadIdx.x; asm volatile("" : "+v"(ti_)); for (int i = ti_; i < ntiles; i += NTHR) lds_te[i] = (int)__hip_atomic_load(mi + 16 + i, __ATOMIC_RELAXED, __HIP_MEMORY_SCOPE_AGENT); } __syncthreads();
                for (int s = 0; s < 4; ++s) {
                    if (!IN(15 + s)) continue;
                    const int tmid = ntiles - QLAST > QTILES ? ntiles - QLAST : QTILES;
                    int xd = 0;
                    if (s >= 1) {
                        const int t0 = s == 1 ? 0 : s == 2 ? QTILES : tmid, t1 = s == 1 ? QTILES : s == 2 ? tmid : ntiles;
                        pg8::Gemm g{(const bf16*)(ws + ((s & 1) ? WS_HQ8 : WS_HQ8B)), (const bf16*)(ws + WS_MD), (t1 - t0) * 256, DM, EDIM, (size_t)EDIM * DM};
                        pg8::GOrder S; S.init(t1 - t0, DM, F.G, cta_id(), 0, t0, lds_te + t0);
                        pg8::EpiPlain8 E{ws + WS_XG, DM, pg8::F8_SY / (pg8::F8_SH * pg8::F8_SD)};
                        pg8::gemm_phase<pg8::EpiPlain8, pg8::GOrder, true, true, true>(F.lds + RING_OFF, g, S, E);
                        xd = ((t1 - t0) * (DM / 256)) % F.G;
                    }
                    if (s <= 2) {
                        const int t0 = s == 0 ? 0 : s == 1 ? QTILES : tmid, t1 = s == 0 ? QTILES : s == 1 ? tmid : ntiles;
                        pg8::Gemm g{(const bf16*)(ws + WS_XG8), (const bf16*)(ws + WS_MGU), (t1 - t0) * 256, 2 * EDIM, DM, (size_t)2 * EDIM * DM};
                        pg8::GOrder S; S.init(t1 - t0, 2 * EDIM, F.G, cta_id(), t0, 0, lds_te + t0);
                        const int nup = (t1 - t0) * (2 * EDIM / 256);
                        if (xd > 0 && xd <= 64 && F.G == 256 && nup % F.G == 0 && nup / F.G >= 3) S.donate(xd);
                        pg8::EpiSwiGLU8 E{ws + ((s & 1) ? WS_HQ8B : WS_HQ8), EDIM};
                        pg8::gemm_phase<pg8::EpiSwiGLU8, pg8::GOrder, true, true, true>(F.lds + RING_OFF, g, S, E);
                    }
                    SEAM(15 + s);
                }
            }
            RUN(25, moe_out_phase(F, l););
        }
    }
#ifdef PROBE_BARWAIT
    {
        gu32* acc = F.ctl + 3968;
        if (threadIdx.x == 0) { const unsigned w = F.MISC[8 + 8]; __hip_atomic_fetch_add(acc, w, __ATOMIC_RELAXED, __HIP_MEMORY_SCOPE_AGENT); }
        GRID_BAR();
        if (blockIdx.x == 0 && threadIdx.x == 0) { unsigned tot = __hip_atomic_load(acc, __ATOMIC_RELAXED, __HIP_MEMORY_SCOPE_AGENT); tot = tot / gridDim.x * PROBE_AMP;
            const unsigned long long t0 = __builtin_amdgcn_s_memrealtime(); while (__builtin_amdgcn_s_memrealtime() - t0 < (unsigned long long)tot) __builtin_amdgcn_s_sleep(8); }
    }
#endif
#undef IN
#undef SEAM
}

extern "C" void kernel_launch(void* const* d_in, const int* in_sizes, int n_in, void* d_out, int out_size, void* d_ws, size_t ws_size, hipStream_t stream) {
    static int grid = 0;
    if (grid == 0) {
        if (n_in != 20 || in_sizes[0] != MROWS * DM || out_size != MROWS * DM || ws_size < WS_END) { fprintf(stderr, "kernel_launch: unexpected shapes (n_in %d, ws %zu); nothing launched\n", n_in, ws_size); grid = -1; return; }
        int dev = 0, cus = 0, per_cu = 0;
        if (hipGetDevice(&dev) != hipSuccess || hipDeviceGetAttribute(&cus, hipDeviceAttributeMultiprocessorCount, dev) != hipSuccess) { grid = -1; return; }
        if (hipFuncSetAttribute((const void*)hymba_fwd, hipFuncAttributeMaxDynamicSharedMemorySize, LDS_BYTES) != hipSuccess) { grid = -1; return; }
        if (hipOccupancyMaxActiveBlocksPerMultiprocessor(&per_cu, (const void*)hymba_fwd, NTHR, LDS_BYTES) != hipSuccess || per_cu < 1) { fprintf(stderr, "kernel_launch: occupancy query reports %d\n", per_cu); }
        (void)hipGetLastError();
        grid = cus;
    }
    if (grid < 0) return;
    if (hipMemsetAsync((char*)d_ws + WS_CTL, 0, CTL_ZERO_BYTES, stream) != hipSuccess) return;
    Args a{};
    for (int i = 0; i < 20; ++i) a.in[i] = (const float*)d_in[i];
    a.out = (float*)d_out; a.ws = (unsigned char*)d_ws;
#if MK_ONE_LAUNCH
    a.ph_lo = 0; a.ph_hi = N_PHASES;
    hipLaunchKernelGGL(hymba_fwd, dim3(grid), dim3(NTHR), LDS_BYTES, stream, a);
#else
    for (int p = 0; p < N_PHASES; ++p) { a.ph_lo = p; a.ph_hi = p + 1; hipLaunchKernelGGL(hymba_fwd, dim3(grid), dim3(NTHR), LDS_BYTES, stream, a); }
#endif
}
```
